# Optimizing an MI355X kernel written in HIP

```python
import math
import jax, jax.numpy as jnp
from jax import lax
import numpy as np

D_MODEL = 1024
BATCH = 8
SEQ = 4096
DEPTH = 1

SSD_HEADS = 8
SSD_HEAD_DIM = 64
SSD_INNER = SSD_HEADS * SSD_HEAD_DIM
SSD_GROUPS = 2
SSD_STATE = 128
SSD_CONV = 4
SSD_CHUNK = 128
SSD_XBC = SSD_INNER + 2 * SSD_GROUPS * SSD_STATE
MLA_HEADS = 8
MLA_NOPE = 64
MLA_ROPE = 32
MLA_QK = MLA_NOPE + MLA_ROPE
MLA_V = 64
MLA_Q_RANK = 384
MLA_KV_RANK = 256
ROPE_THETA = 10000.0
ATTN_BLOCK = 128
MIX_WIDTH = SSD_INNER + MLA_HEADS * MLA_V
IN_WIDTH = SSD_INNER + SSD_XBC + SSD_HEADS + MLA_Q_RANK + MLA_KV_RANK + MLA_ROPE
IN_SPLITS = (SSD_INNER,
             SSD_INNER + SSD_XBC,
             SSD_INNER + SSD_XBC + SSD_HEADS,
             SSD_INNER + SSD_XBC + SSD_HEADS + MLA_Q_RANK,
             SSD_INNER + SSD_XBC + SSD_HEADS + MLA_Q_RANK + MLA_KV_RANK)
MEM_TOKENS = 256
MEM_HEADS = 4
MEM_HEAD_DIM = D_MODEL // MEM_HEADS
D_FF = 4 * D_MODEL
LN_EPS = 1e-5
RMS_EPS = 1e-6
DEEPNORM_ALPHA = (2.0 * DEPTH) ** 0.25
DEEPNORM_BETA = (8.0 * DEPTH) ** -0.25

kernel_name = "hybrid_ssd_mla_memxattn_deepnorm_layer"


def layer_norm(x, g, b):
    xf = x.astype(jnp.float32)
    mu = jnp.mean(xf, axis=-1, keepdims=True)
    var = jnp.mean(jnp.square(xf - mu), axis=-1, keepdims=True)
    return ((xf - mu) * lax.rsqrt(var + LN_EPS) * g.astype(jnp.float32) + b.astype(jnp.float32)).astype(x.dtype)


def rms_norm(x, g):
    xf = x.astype(jnp.float32)
    ms = jnp.mean(jnp.square(xf), axis=-1, keepdims=True)
    return (xf * lax.rsqrt(ms + RMS_EPS) * g.astype(jnp.float32)).astype(x.dtype)


def grouped_rms_norm(y, g, groups):
    b, s, c = y.shape
    yg = y.reshape(b, s, groups, c // groups)
    yg = yg * lax.rsqrt(jnp.mean(jnp.square(yg), axis=-1, keepdims=True) + RMS_EPS)
    return yg.reshape(b, s, c) * g.astype(jnp.float32)


def apply_rope(x, cos, sin):
    half = x.shape[-1] // 2
    xf = x.astype(jnp.float32)
    x1, x2 = xf[..., :half], xf[..., half:]
    return jnp.concatenate([x1 * cos - x2 * sin, x2 * cos + x1 * sin], axis=-1).astype(x.dtype)


def causal_depthwise_conv(u, w, b):
    c = u.shape[-1]
    y = lax.conv_general_dilated(u, w[:, None, :].astype(u.dtype), window_strides=(1,),
                                 padding=[(SSD_CONV - 1, 0)],
                                 dimension_numbers=("NWC", "WIO", "NWC"),
                                 feature_group_count=c)
    return y + b


def segsum(a):
    t = a.shape[-1]
    aa = jnp.broadcast_to(a[..., :, None], a.shape + (t,))
    aa = jnp.where(jnp.tril(jnp.ones((t, t), dtype=bool), -1), aa, 0.0)
    ss = jnp.cumsum(aa, axis=-2)
    return jnp.where(jnp.tril(jnp.ones((t, t), dtype=bool)), ss, -jnp.inf)


def ssd_chunked_scan(x, dt, a_head, bm, cm):
    b, s, h, p = x.shape
    g, n = bm.shape[-2:]
    e = h // g
    L = SSD_CHUNK
    c = s // L
    xf = (x.astype(jnp.float32) * dt[..., None]).reshape(b, c, L, g, e, p)
    a = jnp.moveaxis((dt * a_head).reshape(b, c, L, g, e), 2, -1)
    bc = bm.astype(jnp.float32).reshape(b, c, L, g, n)
    cc = cm.astype(jnp.float32).reshape(b, c, L, g, n)
    a_cs = jnp.cumsum(a, axis=-1)
    decay_ls = jnp.exp(segsum(a))
    cb = jnp.einsum("bclgn,bcsgn->bcgls", cc, bc)
    y_diag = jnp.einsum("bcgls,bcgels,bcsgep->bclgep", cb, decay_ls, xf)
    decay_to_end = jnp.exp(a_cs[..., -1:] - a_cs)
    states = jnp.einsum("bclgn,bcgel,bclgep->bcgepn", bc, decay_to_end, xf)
    chunk_decay = jnp.exp(a_cs[..., -1])

    def step(carry, inp):
        st, dec = inp
        return carry * dec[..., None, None] + st, carry

    init = jnp.zeros((b, g, e, p, n), jnp.float32)
    _, prev = lax.scan(step, init, (jnp.moveaxis(states, 1, 0), jnp.moveaxis(chunk_decay, 1, 0)))
    prev = jnp.moveaxis(prev, 0, 1)
    y_off = jnp.einsum("bclgn,bcgepn,bcgel->bclgep", cc, prev, jnp.exp(a_cs))
    return (y_diag + y_off).reshape(b, s, h, p)


def causal_block_attention(q, k, v, scale):
    b, s, h, d = q.shape
    nb = s // ATTN_BLOCK
    qb = jnp.moveaxis(q.reshape(b, nb, ATTN_BLOCK, h, d), 1, 0)
    k_pos = jnp.arange(s)

    def one_block(args):
        q_blk, i = args
        q_pos = i * ATTN_BLOCK + jnp.arange(ATTN_BLOCK)
        sc = jnp.einsum("bqhd,bkhd->bhqk", q_blk, k).astype(jnp.float32) * scale
        sc = jnp.where(k_pos[None, :] <= q_pos[:, None], sc, -jnp.inf)
        pr = jax.nn.softmax(sc, axis=-1).astype(v.dtype)
        return jnp.einsum("bhqk,bkhd->bqhd", pr, v)

    out = lax.map(one_block, (qb, jnp.arange(nb)))
    return jnp.moveaxis(out, 0, 1).reshape(b, s, h, v.shape[-1])


def hybrid_mixer(h, cos, sin, w_in, conv_w, conv_b, dt_bias, a_log, d_skip, ssd_norm_g,
                 q_norm_g, w_q_up, kv_norm_g, w_kv_up, w_out):
    b, s, _ = h.shape
    proj = h @ w_in
    z, xbc, dt_raw, q_lat, kv_lat, k_r = jnp.split(proj, IN_SPLITS, axis=-1)
    xbc = jax.nn.silu(causal_depthwise_conv(xbc, conv_w, conv_b))
    xs, bm, cm = jnp.split(xbc, [SSD_INNER, SSD_INNER + SSD_GROUPS * SSD_STATE], axis=-1)
    xs = xs.reshape(b, s, SSD_HEADS, SSD_HEAD_DIM)
    bm = bm.reshape(b, s, SSD_GROUPS, SSD_STATE)
    cm = cm.reshape(b, s, SSD_GROUPS, SSD_STATE)
    dt = jax.nn.softplus(dt_raw.astype(jnp.float32) + dt_bias.astype(jnp.float32))
    a_head = -jnp.exp(a_log.astype(jnp.float32))
    y = ssd_chunked_scan(xs, dt, a_head, bm, cm) + xs.astype(jnp.float32) * d_skip.astype(jnp.float32)[:, None]
    y = y.reshape(b, s, SSD_INNER) * jax.nn.silu(z.astype(jnp.float32))
    y = grouped_rms_norm(y, ssd_norm_g, SSD_GROUPS).astype(h.dtype)
    q = (rms_norm(q_lat, q_norm_g) @ w_q_up).reshape(b, s, MLA_HEADS, MLA_QK)
    q = jnp.concatenate([q[..., :MLA_NOPE], apply_rope(q[..., MLA_NOPE:], cos, sin)], axis=-1)
    kv = (rms_norm(kv_lat, kv_norm_g) @ w_kv_up).reshape(b, s, MLA_HEADS, MLA_NOPE + MLA_V)
    k_pe = apply_rope(k_r[:, :, None, :], cos, sin)
    k = jnp.concatenate([kv[..., :MLA_NOPE],
                         jnp.broadcast_to(k_pe, (b, s, MLA_HEADS, MLA_ROPE))], axis=-1)
    v = kv[..., MLA_NOPE:]
    o = causal_block_attention(q, k, v, MLA_QK ** -0.5).reshape(b, s, MLA_HEADS * MLA_V)
    return jnp.concatenate([y, o], axis=-1) @ w_out


def memory_cross_attention(h, mem, w_q, w_k, w_v, w_o):
    b, s, _ = h.shape
    m = mem.shape[1]
    q = (h @ w_q).reshape(b, s, MEM_HEADS, MEM_HEAD_DIM)
    k = (mem @ w_k).reshape(b, m, MEM_HEADS, MEM_HEAD_DIM)
    v = (mem @ w_v).reshape(b, m, MEM_HEADS, MEM_HEAD_DIM)
    sc = jnp.einsum("bshd,bmhd->bhsm", q, k).astype(jnp.float32) * (MEM_HEAD_DIM ** -0.5)
    pr = jax.nn.softmax(sc, axis=-1).astype(v.dtype)
    o = jnp.einsum("bhsm,bmhd->bshd", pr, v).reshape(b, s, D_MODEL)
    return o @ w_o


def sq_relu_mlp(h, w_up, w_down):
    return jnp.square(jax.nn.relu(h @ w_up)) @ w_down


def setup_inputs(seed: int = 0) -> dict:
    key = jax.random.key(seed)
    ks = jax.random.split(key, 32)
    f32 = jnp.float32

    def w(k, shape, fan_in, scale=1.0):
        return jax.random.normal(k, shape, f32) * (fan_in ** -0.5) * scale

    def gain(k, shape):
        return 1.0 + 0.02 * jax.random.normal(k, shape, f32)

    def bias(k, shape):
        return 0.02 * jax.random.normal(k, shape, f32)

    x = jax.random.normal(ks[0], (BATCH, SEQ, D_MODEL), f32)
    mem = jax.random.normal(ks[1], (BATCH, MEM_TOKENS, D_MODEL), f32)
    start = jax.random.randint(ks[2], (BATCH, 1), 0, 4096, dtype=jnp.int32)
    positions = (start + jnp.arange(SEQ, dtype=jnp.int32)[None, :]).astype(jnp.int32)

    dt0 = jnp.exp(jax.random.uniform(ks[3], (DEPTH, SSD_HEADS), f32,
                                     minval=math.log(1e-3), maxval=math.log(1e-1)))
    dt_bias = dt0 + jnp.log(-jnp.expm1(-dt0))
    a_log = jnp.log(jax.random.uniform(ks[4], (DEPTH, SSD_HEADS), f32, minval=1.0, maxval=16.0))
    v_col = (jnp.arange(MLA_NOPE + MLA_V) >= MLA_NOPE)
    kv_scale = jnp.tile(jnp.where(v_col, DEEPNORM_BETA, 1.0), MLA_HEADS).astype(f32)

    return {
        "x": x,
        "mem": mem,
        "positions": positions,
        "ln_in_g": gain(ks[5], (D_MODEL,)),
        "ln_in_b": bias(ks[6], (D_MODEL,)),
        "w_in": w(ks[7], (DEPTH, D_MODEL, IN_WIDTH), D_MODEL),
        "conv_w": w(ks[8], (DEPTH, SSD_CONV, SSD_XBC), SSD_CONV),
        "conv_b": bias(ks[9], (DEPTH, SSD_XBC)),
        "dt_bias": dt_bias,
        "a_log": a_log,
        "d_skip": gain(ks[10], (DEPTH, SSD_HEADS)),
        "ssd_norm_g": gain(ks[11], (DEPTH, SSD_INNER)),
        "q_norm_g": gain(ks[12], (DEPTH, MLA_Q_RANK)),
        "w_q_up": w(ks[13], (DEPTH, MLA_Q_RANK, MLA_HEADS * MLA_QK), MLA_Q_RANK),
        "kv_norm_g": gain(ks[14], (DEPTH, MLA_KV_RANK)),
        "w_kv_up": w(ks[15], (DEPTH, MLA_KV_RANK, MLA_HEADS * (MLA_NOPE + MLA_V)), MLA_KV_RANK) * kv_scale,
        "w_mix_out": w(ks[16], (DEPTH, MIX_WIDTH, D_MODEL), MIX_WIDTH, DEEPNORM_BETA),
        "ln1_g": gain(ks[17], (DEPTH, D_MODEL)),
        "ln1_b": bias(ks[18], (DEPTH, D_MODEL)),
        "w_mem_q": w(ks[19], (DEPTH, D_MODEL, D_MODEL), D_MODEL),
        "w_mem_k": w(ks[20], (DEPTH, D_MODEL, D_MODEL), D_MODEL),
        "w_mem_v": w(ks[21], (DEPTH, D_MODEL, D_MODEL), D_MODEL, DEEPNORM_BETA),
        "w_mem_o": w(ks[22], (DEPTH, D_MODEL, D_MODEL), D_MODEL, DEEPNORM_BETA),
        "ln2_g": gain(ks[23], (DEPTH, D_MODEL)),
        "ln2_b": bias(ks[24], (DEPTH, D_MODEL)),
        "w_up": w(ks[25], (DEPTH, D_MODEL, D_FF), D_MODEL, DEEPNORM_BETA),
        "w_down": w(ks[26], (DEPTH, D_FF, D_MODEL), D_FF, DEEPNORM_BETA),
        "ln3_g": gain(ks[27], (DEPTH, D_MODEL)),
        "ln3_b": bias(ks[28], (DEPTH, D_MODEL)),
    }


def reference(x, mem, positions, ln_in_g, ln_in_b, w_in, conv_w, conv_b, dt_bias, a_log, d_skip,
              ssd_norm_g, q_norm_g, w_q_up, kv_norm_g, w_kv_up, w_mix_out, ln1_g, ln1_b,
              w_mem_q, w_mem_k, w_mem_v, w_mem_o, ln2_g, ln2_b, w_up, w_down, ln3_g, ln3_b):
    half = MLA_ROPE // 2
    inv_freq = jnp.power(ROPE_THETA, -jnp.arange(half, dtype=jnp.float32) / half)
    ang = positions.astype(jnp.float32)[..., None] * inv_freq
    cos = jnp.cos(ang)[:, :, None, :]
    sin = jnp.sin(ang)[:, :, None, :]

    h = layer_norm(x, ln_in_g, ln_in_b)
    for l in range(DEPTH):
        mix = hybrid_mixer(h, cos, sin, w_in[l], conv_w[l], conv_b[l], dt_bias[l], a_log[l],
                           d_skip[l], ssd_norm_g[l], q_norm_g[l], w_q_up[l], kv_norm_g[l],
                           w_kv_up[l], w_mix_out[l])
        h = layer_norm(DEEPNORM_ALPHA * h + mix, ln1_g[l], ln1_b[l])
        xa = memory_cross_attention(h, mem, w_mem_q[l], w_mem_k[l], w_mem_v[l], w_mem_o[l])
        h = layer_norm(DEEPNORM_ALPHA * h + xa, ln2_g[l], ln2_b[l])
        ff = sq_relu_mlp(h, w_up[l], w_down[l])
        h = layer_norm(DEEPNORM_ALPHA * h + ff, ln3_g[l], ln3_b[l])
    return h
```

```cpp
#include <hip/hip_runtime.h>
#include <cstdio>
#include <cstdint>

#ifndef MK_PER_PHASE
#define MK_PER_PHASE 1
#endif

#define LAS __attribute__((address_space(3)))
#define GAS __attribute__((address_space(1)))
typedef unsigned short bf16;
typedef short bf16x8 __attribute__((ext_vector_type(8)));
typedef short s16x4 __attribute__((ext_vector_type(4)));
typedef float f32x2 __attribute__((ext_vector_type(2)));
typedef float f32x4 __attribute__((ext_vector_type(4)));
typedef float f32x16 __attribute__((ext_vector_type(16)));
typedef unsigned u32x2 __attribute__((ext_vector_type(2)));
typedef unsigned u32x4 __attribute__((ext_vector_type(4)));

constexpr int BATCH = 8, SEQ = 4096, DM = 1024, M = BATCH * SEQ;
constexpr int NPROJ = 2304;
constexpr int PC_Z = 0, PC_XBC = 512, PC_QL = 1536, PC_KVL = 1920, PC_KR = 2176, PC_DT = 2208;
constexpr int NQ = 768, NKV = 1024, FF = 4096, MEMT = 256;
constexpr int NCHUNK = 32, CHUNK = 128;
constexpr float LN_EPS = 1e-5f, RMS_EPS = 1e-6f;
constexpr float ALPHA = 1.189207115002721f;
constexpr float LOG2E = 1.4426950408889634f;
constexpr float QSCALE = 0.10206207261596577f * LOG2E;
constexpr float MSCALE = 0.0625f * LOG2E;

__device__ __forceinline__ float bf2f(unsigned short x) { return __uint_as_float((unsigned)x << 16); }
__device__ __forceinline__ unsigned cvt_pk_bf16(float lo, float hi) { unsigned r; asm volatile("v_cvt_pk_bf16_f32 %0, %1, %2" : "=v"(r) : "v"(lo), "v"(hi)); return r; }
__device__ __forceinline__ float fast_exp2(float x) { return __builtin_amdgcn_exp2f(x); }
__device__ __forceinline__ float fast_exp(float x) { return __builtin_amdgcn_exp2f(x * LOG2E); }
__device__ __forceinline__ float silu_f(float v) { return v * __builtin_amdgcn_rcpf(1.f + fast_exp(-v)); }

namespace pg8 {
constexpr int BM = 256, BK = 64, HALF = 128, HTB = HALF * BK * 2, STAGE_BYTES = 8 * HTB, NXCD = 8, WGM = 8;
__host__ __device__ __forceinline__ int lds_byte(int r, int c) { const int st = (r >> 4) * 2 + (c >> 5), rr = r & 15, cc = c & 31, ob = rr * 64 + cc * 2; return st * 1024 + (ob ^ (((ob >> 9) & 1) << 5)); }
__host__ __device__ __forceinline__ void stage_rc(int b, int& R, int& C) { const int st = b / 1024, sb = b % 1024, swz = sb ^ (((sb >> 9) & 1) << 5); R = (st >> 1) * 16 + swz / 64; C = (st & 1) * 32 + (swz % 64) / 2; }
__host__ __device__ __forceinline__ int perm32(int rho) { const int n = rho >> 4, i = rho & 15; return 8 * (i >> 2) + 4 * n + (i & 3); }

struct Unit { int pm, pn; };
struct Gemm { const bf16* A; const bf16* Bt; int M, N, K, lda, ldb; };

struct StaticOrder {
    int nM, nN, nwg, G, c;
    __host__ __device__ void init(int M_, int N_, int G_, int c_) { nM = M_ / BM; nN = N_ / BM; nwg = nM * nN; G = G_; c = c_; }
    __host__ __device__ bool next(int i, Unit& u) const {
        const long L = (long)i * G + c; if (L >= nwg) return false;
        int wgid = (int)L; { const int q = nwg / NXCD, r = nwg % NXCD, xcd = wgid % NXCD, off = wgid / NXCD; wgid = (xcd < r ? xcd * (q + 1) : r * (q + 1) + (xcd - r) * q) + off; }
        const int nig = WGM * nN, gid = wgid / nig, fm = gid * WGM, gsz = (nM - fm) < WGM ? (nM - fm) : WGM;
        u.pm = fm + ((wgid % nig) % gsz); u.pn = (wgid % nig) / gsz; return true;
    }
    __device__ __forceinline__ void a_ready(const Unit&) const {}
    __device__ __forceinline__ void done(const Unit&) const {}
};

enum { EK_PROJ = 0, EK_QUP = 1, EK_KVUP = 2, EK_PLAIN = 3, EK_SQRELU = 4 };
struct EpiP {
    static constexpr bool PERM = true, AFTER_DRAIN = false;
    int kind; bf16* O; int ldc;
    float* ssq; float* dt; const float* dt_bias;
    const float* ssq_in; const float* cosT; const float* sinT;
    int split_cols; long split_stride;
    __device__ __forceinline__ void operator()(const f32x4 (&acc)[2][2][4][2], const Unit& u, int wr, int wc, int fr, int fq) const {
        const int row0 = u.pm * BM + wr * 64 + fr;
#pragma unroll
        for (int ai = 0; ai < 2; ++ai)
#pragma unroll
            for (int m = 0; m < 4; ++m) {
                const int row = row0 + ai * HALF + m * 16;
                float rs = 1.f;
                if (kind == EK_QUP) { const f32x4* s = (const f32x4*)(ssq_in + (size_t)row * 24); const f32x4 a = s[0], b = s[1], c = s[2];
                    const float t = ((a[0] + a[1]) + (a[2] + a[3])) + ((b[0] + b[1]) + (b[2] + b[3])) + ((c[0] + c[1]) + (c[2] + c[3]));
                    rs = __builtin_amdgcn_rsqf(t * (1.f / 384.f) + RMS_EPS); }
                else if (kind == EK_KVUP) { const f32x4* s = (const f32x4*)(ssq_in + (size_t)row * 24); const f32x4 a = s[3], b = s[4];
                    const float t = ((a[0] + a[1]) + (a[2] + a[3])) + ((b[0] + b[1]) + (b[2] + b[3]));
                    rs = __builtin_amdgcn_rsqf(t * (1.f / 256.f) + RMS_EPS); }
#pragma unroll
                for (int bj = 0; bj < 2; ++bj) {
                    const int cb = u.pn * BM + bj * HALF + wc * 32 + 8 * fq;
                    float v[8];
#pragma unroll
                    for (int e = 0; e < 4; ++e) { v[e] = acc[ai][bj][m][0][e]; v[4 + e] = acc[ai][bj][m][1][e]; }
                    bf16* dst = O + (size_t)row * ldc + cb;
                    if (kind == EK_PROJ) {
                        if (u.pn >= 6) {
                            float s = 0.f;
#pragma unroll
                            for (int e = 0; e < 8; ++e) s += v[e] * v[e];
                            s += __shfl_xor(s, 16); s += __shfl_xor(s, 32);
                            const int grp = (u.pn * BM + bj * HALF + wc * 32 - PC_QL) >> 5;
                            if (fq == 0 && grp >= 0 && grp < 20) ssq[(size_t)row * 24 + grp] = s;
                            if (cb == PC_DT) {
                                f32x4 d0, d1;
#pragma unroll
                                for (int e = 0; e < 8; ++e) { const float x = v[e] + dt_bias[e]; const float sp = fmaxf(x, 0.f) + log1pf(__expf(-fabsf(x))); if (e < 4) d0[e] = sp; else d1[e - 4] = sp; }
                                *(f32x4*)(dt + (size_t)row * 8) = d0; *(f32x4*)(dt + (size_t)row * 8 + 4) = d1;
                            }
                        }
                    } else if (kind == EK_QUP) {
#pragma unroll
                        for (int e = 0; e < 8; ++e) v[e] *= rs;
                        const int d = cb % 96;
                        if (d >= 64) { const int o8 = (d - 64) >> 3;
                            const f32x4 cs = *(const f32x4*)(cosT + (size_t)row * 16 + 4 * o8), sn = *(const f32x4*)(sinT + (size_t)row * 16 + 4 * o8);
#pragma unroll
                            for (int j = 0; j < 4; ++j) { const float x1 = v[2 * j], x2 = v[2 * j + 1]; v[2 * j] = x1 * cs[j] - x2 * sn[j]; v[2 * j + 1] = x2 * cs[j] + x1 * sn[j]; } }
                    } else if (kind == EK_KVUP) {
#pragma unroll
                        for (int e = 0; e < 8; ++e) v[e] *= rs;
                    } else if (kind == EK_SQRELU) {
#pragma unroll
                        for (int e = 0; e < 8; ++e) { const float t = fmaxf(v[e], 0.f); v[e] = t * t; }
                    } else {
                        if (split_cols) { const int t = cb / split_cols; dst = O + (size_t)t * split_stride + (size_t)row * ldc + (cb - t * split_cols); }
                    }
                    u32x4 w; w.x = cvt_pk_bf16(v[0], v[1]); w.y = cvt_pk_bf16(v[2], v[3]); w.z = cvt_pk_bf16(v[4], v[5]); w.w = cvt_pk_bf16(v[6], v[7]);
                    *(u32x4*)dst = w;
                }
            }
    }
};
struct EpiR {
    static constexpr bool PERM = false, AFTER_DRAIN = false;
    const float* Uold; const float* stats; const float* g; const float* b; float* Unew;
    __device__ __forceinline__ void operator()(const f32x4 (&acc)[2][2][4][2], const Unit& u, int wr, int wc, int fr, int fq) const {
        const int row0 = u.pm * BM + wr * 64 + fr, col0 = u.pn * BM + wc * 32 + 4 * fq;
        f32x4 gv[2][2], bv[2][2];
#pragma unroll
        for (int bj = 0; bj < 2; ++bj)
#pragma unroll
            for (int n = 0; n < 2; ++n) { gv[bj][n] = *(const f32x4*)(g + col0 + bj * HALF + n * 16); bv[bj][n] = *(const f32x4*)(b + col0 + bj * HALF + n * 16); }
#pragma unroll
        for (int ai = 0; ai < 2; ++ai)
#pragma unroll
            for (int m = 0; m < 4; ++m) {
                const int row = row0 + ai * HALF + m * 16;
                const f32x2 st = *(const f32x2*)(stats + (size_t)row * 2);
                const size_t off = (size_t)row * DM + col0;
#pragma unroll
                for (int bj = 0; bj < 2; ++bj)
#pragma unroll
                    for (int n = 0; n < 2; ++n) {
                        const f32x4 uo = *(const f32x4*)(Uold + off + bj * HALF + n * 16);
                        const f32x4 h = (uo - st.x) * st.y * gv[bj][n] + bv[bj][n];
                        *(f32x4*)(Unew + off + bj * HALF + n * 16) = h * ALPHA + acc[ai][bj][m][n];
                    }
            }
    }
};

template <class Epi, class Sched, bool ALIGN_EPI = false, bool SP2 = false>
__device__ __forceinline__ void gemm_phase(LAS unsigned char* lds, const Gemm g, const Sched& S, const Epi& E) {
    const int tid = threadIdx.x, wid = __builtin_amdgcn_readfirstlane(tid >> 6), lane = tid & 63, wr = wid >> 2, wc = wid & 3, fr = lane & 15, fq = lane >> 4;
    const int K = g.K, nt = K / BK;
    unsigned voffA[2], voffB[2];
#pragma unroll
    for (int i = 0; i < 2; ++i) { int R, C; stage_rc(tid * 16 + i * 8192, R, C); const int Rb = Epi::PERM ? ((R & ~31) + perm32(R & 31)) : R;
        voffA[i] = (unsigned)(R * g.lda + C) * 2u; voffB[i] = (unsigned)(Rb * g.ldb + C) * 2u; }
    const size_t kstep = (size_t)(BK * 2);
    const size_t hstepA = (size_t)HALF * g.lda * 2, hstepB = (size_t)HALF * g.ldb * 2;
    const size_t tstepA = 2 * hstepA, tstepB = 2 * hstepB;
    const unsigned ldsw = (unsigned)wid * 1024u;
    const int aoff = lds_byte(wr * 64 + fr, fq * 8), boff = lds_byte(wc * 32 + fr, fq * 8);
#define PG8_SA(b, h) (((b) * 2 + (h)) * HTB)
#define PG8_SB(b, h) ((4 + (b) * 2 + (h)) * HTB)
#define PG8_STAGE(bufoff, gbase, voff) do { _Pragma("unroll") for (int _i = 0; _i < 2; ++_i) \
        __builtin_amdgcn_global_load_lds((const unsigned*)((const char*)(gbase) + (voff)[_i]), (LAS unsigned*)(lds + (bufoff) + ldsw + _i * 8192), 16, 0, 0); } while (0)
#define PG8_LDA(dst, b, h) do { _Pragma("unroll") for (int m = 0; m < 4; ++m) _Pragma("unroll") for (int k = 0; k < 2; ++k) dst[m][k] = *(const LAS bf16x8*)(lds + PG8_SA(b, h) + aoff + m * 2048 + k * 1024); } while (0)
#define PG8_LDB(dst, b, h) do { _Pragma("unroll") for (int n = 0; n < 2; ++n) _Pragma("unroll") for (int k = 0; k < 2; ++k) dst[n][k] = *(const LAS bf16x8*)(lds + PG8_SB(b, h) + boff + n * 2048 + k * 1024); } while (0)
#define PG8_MMA(ai, bj, At, Bt) do { __builtin_amdgcn_s_setprio(1); _Pragma("unroll") for (int m = 0; m < 4; ++m) _Pragma("unroll") for (int n = 0; n < 2; ++n) _Pragma("unroll") for (int k = 0; k < 2; ++k) \
        acc[ai][bj][m][n] = __builtin_amdgcn_mfma_f32_16x16x32_bf16(Bt[n][k], At[m][k], acc[ai][bj][m][n], 0, 0, 0); __builtin_amdgcn_s_setprio(0); } while (0)
#define PG8_WAIT_V(n) asm volatile("s_waitcnt vmcnt(" #n ")" ::: "memory")
#define PG8_WAIT_L(n) asm volatile("s_waitcnt lgkmcnt(" #n ")" ::: "memory")
#define PG8_BAR __builtin_amdgcn_s_barrier()
#define PG8_SCHED __builtin_amdgcn_sched_barrier(0)
    Unit cur, nxt; int ui = 0;
    if (!S.next(0, cur)) return;
    f32x4 acc[2][2][4][2];
#pragma unroll
    for (int a = 0; a < 2; ++a)
#pragma unroll
        for (int b = 0; b < 2; ++b)
#pragma unroll
            for (int m = 0; m < 4; ++m)
#pragma unroll
                for (int n = 0; n < 2; ++n) acc[a][b][m][n] = (f32x4){0.f, 0.f, 0.f, 0.f};
    bf16x8 At[4][2], B0[2][2], B1[2][2];
    const char* cA = (const char*)g.A + (size_t)cur.pm * tstepA; const char* cB = (const char*)g.Bt + (size_t)cur.pn * tstepB;
    S.a_ready(cur);
    if constexpr (SP2) {
        PG8_STAGE(PG8_SB(0, 0), cB, voffB); PG8_STAGE(PG8_SB(0, 1), cB + hstepB, voffB); PG8_STAGE(PG8_SA(0, 0), cA, voffA); PG8_STAGE(PG8_SA(0, 1), cA + hstepA, voffA);
        if (wr == 1) PG8_BAR;
        PG8_WAIT_V(2); PG8_BAR;
        PG8_STAGE(PG8_SB(1, 0), cB + kstep, voffB); PG8_STAGE(PG8_SA(1, 0), cA + kstep, voffA); PG8_STAGE(PG8_SB(1, 1), cB + hstepB + kstep, voffB);
        PG8_WAIT_V(6); PG8_BAR;
    } else {
        PG8_STAGE(PG8_SB(0, 0), cB, voffB); PG8_STAGE(PG8_SA(0, 0), cA, voffA); PG8_STAGE(PG8_SB(0, 1), cB + hstepB, voffB); PG8_STAGE(PG8_SA(0, 1), cA + hstepA, voffA);
        if (wr == 1) PG8_BAR;
        PG8_WAIT_V(4); PG8_BAR;
        PG8_STAGE(PG8_SB(1, 0), cB + kstep, voffB); PG8_STAGE(PG8_SA(1, 0), cA + kstep, voffA); PG8_STAGE(PG8_SB(1, 1), cB + hstepB + kstep, voffB);
        PG8_WAIT_V(6); PG8_BAR;
    }
    for (;;) {
        const bool has_next = S.next(ui + 1, nxt);
        const char* nA = has_next ? (const char*)g.A + (size_t)nxt.pm * tstepA : cA; const char* nB = has_next ? (const char*)g.Bt + (size_t)nxt.pn * tstepB : cB;
        for (int t = 0; t < nt; t += 2) {
            const bool last = (t == nt - 2);
            const char* a1 = cA + (size_t)(t + 1) * kstep;
            const char* a2 = last ? nA : cA + (size_t)(t + 2) * kstep; const char* b2 = last ? nB : cB + (size_t)(t + 2) * kstep;
            const char* a3 = a2 + kstep; const char* b3 = b2 + kstep;
            if (last && has_next) S.a_ready(nxt);
            if constexpr (SP2) {
            PG8_LDB(B0, 0, 0); PG8_LDB(B1, 0, 1); PG8_SCHED; PG8_LDA(At, 0, 0); PG8_STAGE(PG8_SA(1, 1), a1 + hstepA, voffA);
            PG8_WAIT_V(8); PG8_WAIT_L(0); PG8_BAR; PG8_MMA(0, 0, At, B0); PG8_MMA(0, 1, At, B1); PG8_BAR; PG8_SCHED;
            PG8_LDA(At, 0, 1); PG8_STAGE(PG8_SB(0, 0), b2, voffB); PG8_STAGE(PG8_SB(0, 1), b2 + hstepB, voffB); PG8_STAGE(PG8_SA(0, 0), a2, voffA);
            PG8_WAIT_V(8); PG8_WAIT_L(0); PG8_BAR; PG8_MMA(1, 0, At, B0); PG8_MMA(1, 1, At, B1); PG8_BAR; PG8_SCHED;
            PG8_LDB(B0, 1, 0); PG8_LDB(B1, 1, 1); PG8_SCHED; PG8_LDA(At, 1, 0); PG8_STAGE(PG8_SA(0, 1), a2 + hstepA, voffA);
            PG8_WAIT_V(8); PG8_WAIT_L(0); PG8_BAR; PG8_MMA(0, 0, At, B0); PG8_MMA(0, 1, At, B1); PG8_BAR; PG8_SCHED;
            PG8_LDA(At, 1, 1); PG8_STAGE(PG8_SB(1, 0), b3, voffB); PG8_STAGE(PG8_SB(1, 1), b3 + hstepB, voffB); PG8_STAGE(PG8_SA(1, 0), a3, voffA);
            PG8_WAIT_V(8); PG8_WAIT_L(0); PG8_BAR; PG8_MMA(1, 0, At, B0); PG8_MMA(1, 1, At, B1); PG8_BAR; PG8_SCHED;
            } else {
            PG8_LDB(B0, 0, 0); PG8_SCHED; PG8_LDA(At, 0, 0); PG8_STAGE(PG8_SA(1, 1), a1 + hstepA, voffA);
            PG8_WAIT_L(8); PG8_BAR; PG8_WAIT_L(0); PG8_MMA(0, 0, At, B0); PG8_BAR; PG8_SCHED;
            PG8_LDB(B1, 0, 1); PG8_STAGE(PG8_SB(0, 0), b2, voffB);
            PG8_BAR; PG8_WAIT_L(0); PG8_MMA(0, 1, At, B1); PG8_BAR;
            PG8_LDA(At, 0, 1); PG8_STAGE(PG8_SA(0, 0), a2, voffA);
            PG8_BAR; PG8_WAIT_L(0); PG8_MMA(1, 0, At, B0); PG8_BAR; PG8_SCHED;
            PG8_STAGE(PG8_SB(0, 1), b2 + hstepB, voffB);
            PG8_WAIT_V(6); PG8_BAR; PG8_MMA(1, 1, At, B1); PG8_BAR;
            PG8_LDB(B0, 1, 0); PG8_SCHED; PG8_LDA(At, 1, 0); PG8_STAGE(PG8_SA(0, 1), a2 + hstepA, voffA);
            PG8_WAIT_L(8); PG8_BAR; PG8_WAIT_L(0); PG8_MMA(0, 0, At, B0); PG8_BAR; PG8_SCHED;
            PG8_LDB(B1, 1, 1); PG8_STAGE(PG8_SB(1, 0), b3, voffB);
            PG8_BAR; PG8_WAIT_L(0); PG8_MMA(0, 1, At, B1); PG8_BAR;
            PG8_LDA(At, 1, 1); PG8_STAGE(PG8_SA(1, 0), a3, voffA);
            PG8_BAR; PG8_WAIT_L(0); PG8_MMA(1, 0, At, B0); PG8_BAR; PG8_SCHED;
            PG8_STAGE(PG8_SB(1, 1), b3 + hstepB, voffB);
            PG8_WAIT_V(6); PG8_BAR; PG8_MMA(1, 1, At, B1); PG8_BAR;
            }
        }
        if constexpr (ALIGN_EPI) { if (wr == 0) PG8_BAR; }
        if constexpr (!Epi::AFTER_DRAIN) { E(acc, cur, wr, wc, fr, fq); S.done(cur); }
        if (!has_next) break;
#pragma unroll
        for (int a = 0; a < 2; ++a)
#pragma unroll
            for (int b = 0; b < 2; ++b)
#pragma unroll
                for (int m = 0; m < 4; ++m)
#pragma unroll
                    for (int n = 0; n < 2; ++n) acc[a][b][m][n] = (f32x4){0.f, 0.f, 0.f, 0.f};
        cur = nxt; cA = nA; cB = nB; ++ui;
        if constexpr (ALIGN_EPI) { if (wr == 1) PG8_BAR; }
    }
    PG8_WAIT_V(0);
    if constexpr (!ALIGN_EPI) { if (wr == 0) PG8_BAR; }
    PG8_BAR;
#undef PG8_SA
#undef PG8_SB
#undef PG8_STAGE
#undef PG8_LDA
#undef PG8_LDB
#undef PG8_MMA
#undef PG8_WAIT_V
#undef PG8_WAIT_L
#undef PG8_BAR
#undef PG8_SCHED
}
}

namespace att {
__device__ __forceinline__ int crow(int r, int hi) { return (r & 3) + 8 * (r >> 2) + 4 * hi; }
typedef short v4i16_t __attribute__((ext_vector_type(4)));
__device__ __forceinline__ s16x4 vtr(const char* p) { return __builtin_bit_cast(s16x4, __builtin_amdgcn_ds_read_tr16_b64_v4i16((LAS v4i16_t*)(unsigned)(uintptr_t)p)); }
__device__ __forceinline__ float xh_max(float v) { auto rr = __builtin_amdgcn_permlane32_swap(__float_as_uint(v), __float_as_uint(v), false, false); return fmaxf(__uint_as_float(rr[0]), __uint_as_float(rr[1])); }
__device__ __forceinline__ float xh_sum(float v) { auto rr = __builtin_amdgcn_permlane32_swap(__float_as_uint(v), __float_as_uint(v), false, false); return __uint_as_float(rr[0]) + __uint_as_float(rr[1]); }

__device__ __forceinline__ void softmax_tile(f32x16& p0, f32x16& p1, float& m, float& l, float& alpha) {
    float pm = fmaxf(p0[0], p1[0]);
#pragma unroll
    for (int r = 1; r < 16; ++r) pm = fmaxf(pm, fmaxf(p0[r], p1[r]));
    pm = xh_max(pm);
    const float mn = fmaxf(m, pm); alpha = fast_exp2(m - mn); m = mn;
    float ps = 0.f;
#pragma unroll
    for (int r = 0; r < 16; ++r) { p0[r] = fast_exp2(p0[r] - mn); p1[r] = fast_exp2(p1[r] - mn); ps += p0[r] + p1[r]; }
    ps = xh_sum(ps);
    l = l * alpha + ps;
}
#define ATT_PKW(P, B) cvt_pk_bf16(P[B], P[B + 1])
#define ATT_PACK(P0, P1) \
    const u32x4 pw0 = {ATT_PKW(P0, 0), ATT_PKW(P0, 2), ATT_PKW(P0, 4), ATT_PKW(P0, 6)}, pw1 = {ATT_PKW(P0, 8), ATT_PKW(P0, 10), ATT_PKW(P0, 12), ATT_PKW(P0, 14)}, \
                pw2 = {ATT_PKW(P1, 0), ATT_PKW(P1, 2), ATT_PKW(P1, 4), ATT_PKW(P1, 6)}, pw3 = {ATT_PKW(P1, 8), ATT_PKW(P1, 10), ATT_PKW(P1, 12), ATT_PKW(P1, 14)}
#define ATT_VFR(L, H) (bf16x8){L[0], L[1], L[2], L[3], H[0], H[1], H[2], H[3]}

constexpr int S_K = 0, S_V = 12288, S_WS = 20480, S_OST = S_WS + 8 * 256, S_BYTES = S_OST + 8 * 4096;
__device__ __forceinline__ void self_unit(int b, int h, int qb, const bf16* Q, const bf16* KV, const bf16* KPE, bf16* YO, char* shm) {
    const int tid = threadIdx.x, lane = tid & 63, r32 = lane & 31, hi = lane >> 5; const int wid = __builtin_amdgcn_readfirstlane(tid >> 6);
    const long rowbase = (long)b * SEQ; const int q0 = qb * 256;
    const bf16* Qw = Q + (rowbase + q0 + wid * 32 + r32) * NQ + h * 96 + hi * 8;
    bf16x8 qr[6];
#pragma unroll
    for (int d0 = 0; d0 < 6; ++d0) qr[d0] = *(const bf16x8*)(Qw + d0 * 16);
    float* wsf = (float*)(shm + S_WS) + wid * 64;
    const int NT = (q0 + 256) / 64;
    const int srow = tid & 63, sch = tid >> 6;
    const bf16* kn_src = KV + (rowbase + srow) * NKV + h * 64 + sch * 8;
    const bf16* kp_src = KPE + (rowbase + srow) * 32 + (sch & 3) * 8;
    const bf16* v_src = KV + (rowbase + srow) * NKV + 512 + h * 64 + sch * 8;
    char* kn_dst = shm + S_K + sch * 1024 + srow * 16;
    char* kp_dst = shm + S_K + (8 + (sch & 3)) * 1024 + srow * 16;
    char* v_dst = shm + S_V + (sch >> 2) * 4096 + srow * 64 + (sch & 3) * 16;
    const char* kb = shm + S_K + hi * 1024 + r32 * 16;
    const char* vb = shm + S_V + ((lane >> 4) & 1) * 32 + (lane & 3) * 8 + (4 * hi + ((lane & 15) >> 2)) * 64;
    float m_reg = -1e30f, l_reg = 0.f; f32x16 o[2]; o[0] = f32x16{}; o[1] = f32x16{};
    const int qrel = wid * 32 + r32;
    bf16x8 sk0, sk1 = bf16x8{}, sv;
    sk0 = *(const bf16x8*)kn_src; if (tid < 256) sk1 = *(const bf16x8*)kp_src; sv = *(const bf16x8*)v_src;
    for (int t = 0; t < NT; ++t) {
        __syncthreads();
        *(bf16x8*)kn_dst = sk0; if (tid < 256) *(bf16x8*)kp_dst = sk1; *(bf16x8*)v_dst = sv;
        __syncthreads();
        if (t + 1 < NT) { const long ko = (long)(t + 1) * 64;
            sk0 = *(const bf16x8*)(kn_src + ko * NKV); if (tid < 256) sk1 = *(const bf16x8*)(kp_src + ko * 32); sv = *(const bf16x8*)(v_src + ko * NKV); }
        f32x16 p0 = f32x16{}, p1 = f32x16{};
#pragma unroll
        for (int d0 = 0; d0 < 6; ++d0) {
            const bf16x8 k0 = *(const bf16x8*)(kb + d0 * 2048), k1 = *(const bf16x8*)(kb + d0 * 2048 + 512);
            p0 = __builtin_amdgcn_mfma_f32_32x32x16_bf16(k0, qr[d0], p0, 0, 0, 0);
            p1 = __builtin_amdgcn_mfma_f32_32x32x16_bf16(k1, qr[d0], p1, 0, 0, 0);
        }
        const int jb = t - (NT - 4);
        if (jb >= 0) { const int kbase = 64 * jb + 4 * hi;
#pragma unroll
            for (int r = 0; r < 16; ++r) { const int kv = kbase + (r & 3) + 8 * (r >> 2); if (kv > qrel) p0[r] = -INFINITY; if (kv + 32 > qrel) p1[r] = -INFINITY; } }
        float alpha;
        softmax_tile(p0, p1, m_reg, l_reg, alpha);
        if (__any(alpha < 1.f)) {
            if (hi == 0) wsf[r32] = alpha;
            asm volatile("s_waitcnt lgkmcnt(0)" ::: "memory");
#pragma unroll
            for (int r = 0; r < 16; ++r) { const float a = wsf[crow(r, hi)]; o[0][r] *= a; o[1][r] *= a; }
        }
        ATT_PACK(p0, p1);
#pragma unroll
        for (int db = 0; db < 2; ++db) {
            const s16x4 l0 = vtr(vb + db * 4096), h0 = vtr(vb + db * 4096 + 512), l1 = vtr(vb + db * 4096 + 1024), h1 = vtr(vb + db * 4096 + 1536);
            const s16x4 l2 = vtr(vb + db * 4096 + 2048), h2 = vtr(vb + db * 4096 + 2560), l3 = vtr(vb + db * 4096 + 3072), h3 = vtr(vb + db * 4096 + 3584);
            o[db] = __builtin_amdgcn_mfma_f32_32x32x16_bf16(__builtin_bit_cast(bf16x8, pw0), ATT_VFR(l0, h0), o[db], 0, 0, 0);
            o[db] = __builtin_amdgcn_mfma_f32_32x32x16_bf16(__builtin_bit_cast(bf16x8, pw1), ATT_VFR(l1, h1), o[db], 0, 0, 0);
            o[db] = __builtin_amdgcn_mfma_f32_32x32x16_bf16(__builtin_bit_cast(bf16x8, pw2), ATT_VFR(l2, h2), o[db], 0, 0, 0);
            o[db] = __builtin_amdgcn_mfma_f32_32x32x16_bf16(__builtin_bit_cast(bf16x8, pw3), ATT_VFR(l3, h3), o[db], 0, 0, 0);
        }
    }
    if (hi == 0) wsf[32 + r32] = l_reg;
    asm volatile("s_waitcnt lgkmcnt(0)" ::: "memory");
    bf16* stg = (bf16*)(shm + S_OST) + wid * 2048;
#pragma unroll
    for (int r = 0; r < 16; ++r) { const int orow = crow(r, hi); const float rl = __builtin_amdgcn_rcpf(wsf[32 + orow]);
#pragma unroll
        for (int db = 0; db < 2; ++db) stg[orow * 64 + db * 32 + r32] = (bf16)(cvt_pk_bf16(o[db][r] * rl, 0.f) & 0xffffu); }
    asm volatile("s_waitcnt lgkmcnt(0)" ::: "memory");
    bf16* Ow = YO + (rowbase + q0 + wid * 32) * DM + 512 + h * 64;
#pragma unroll
    for (int i = 0; i < 4; ++i) { const int row = i * 8 + (lane >> 3), ch = lane & 7; const u32x4 v = *(const u32x4*)(stg + row * 64 + ch * 8); *(u32x4*)(Ow + (long)row * DM + ch * 8) = v; }
}

constexpr int X_K = 0, X_V = 32768, X_WS = 65536, X_OST = X_WS + 8 * 256, X_BYTES = X_OST + 8 * 8192;
__device__ __forceinline__ void cross_unit(int b, int h, int qt, const bf16* QM, const bf16* KM, const bf16* VM, bf16* OM, char* shm) {
    const int tid = threadIdx.x, lane = tid & 63, r32 = lane & 31, hi = lane >> 5; const int wid = __builtin_amdgcn_readfirstlane(tid >> 6);
    const int qg = wid >> 1, dh = wid & 1;
    const long qrow0 = (long)b * SEQ + qt * 128 + qg * 32;
    const bf16* Qw = QM + (qrow0 + r32) * DM + h * 256 + hi * 8;
    float* wsf = (float*)(shm + X_WS) + wid * 64;
    const int srow = tid & 63, sch = tid >> 6;
    const bf16* k_src = KM + ((long)b * MEMT + srow) * DM + h * 256 + sch * 8;
    const bf16* v_src = VM + ((long)b * MEMT + srow) * DM + h * 256 + sch * 8;
    const char* kb = shm + X_K + hi * 1024 + r32 * 16;
    const char* vb = shm + X_V + dh * 16384 + ((lane >> 4) & 1) * 32 + (lane & 3) * 8 + (4 * hi + ((lane & 15) >> 2)) * 64;
    float m_reg = -1e30f, l_reg = 0.f; f32x16 o[4];
#pragma unroll
    for (int d = 0; d < 4; ++d) o[d] = f32x16{};
    bf16x8 sg[4];
#pragma unroll
    for (int it = 0; it < 4; ++it) sg[it] = *(const bf16x8*)(k_src + it * 64);
    for (int t = 0; t < 4; ++t) {
        __syncthreads();
#pragma unroll
        for (int it = 0; it < 4; ++it) { const int ch = it * 8 + sch; *(bf16x8*)(shm + X_K + ch * 1024 + srow * 16) = sg[it]; }
        __syncthreads();
#pragma unroll
        for (int it = 0; it < 4; ++it) sg[it] = *(const bf16x8*)(v_src + (long)t * 64 * DM + it * 64);
        f32x16 p0 = f32x16{}, p1 = f32x16{};
        const bf16* Qt = Qw; asm volatile("" : "+v"(Qt));
#pragma unroll
        for (int d0 = 0; d0 < 16; ++d0) {
            const bf16x8 qf = *(const bf16x8*)(Qt + d0 * 16);
            const bf16x8 k0 = *(const bf16x8*)(kb + d0 * 2048), k1 = *(const bf16x8*)(kb + d0 * 2048 + 512);
            p0 = __builtin_amdgcn_mfma_f32_32x32x16_bf16(k0, qf, p0, 0, 0, 0);
            p1 = __builtin_amdgcn_mfma_f32_32x32x16_bf16(k1, qf, p1, 0, 0, 0);
        }
#pragma unroll
        for (int it = 0; it < 4; ++it) { const int ch = it * 8 + sch; *(bf16x8*)(shm + X_V + (ch >> 2) * 4096 + srow * 64 + (ch & 3) * 16) = sg[it]; }
        __syncthreads();
        if (t + 1 < 4) {
#pragma unroll
            for (int it = 0; it < 4; ++it) sg[it] = *(const bf16x8*)(k_src + (long)(t + 1) * 64 * DM + it * 64);
        }
        float alpha;
        softmax_tile(p0, p1, m_reg, l_reg, alpha);
        if (__any(alpha < 1.f)) {
            if (hi == 0) wsf[r32] = alpha;
            asm volatile("s_waitcnt lgkmcnt(0)" ::: "memory");
#pragma unroll
            for (int r = 0; r < 16; ++r) { const float a = wsf[crow(r, hi)];
#pragma unroll
                for (int d = 0; d < 4; ++d) o[d][r] *= a; }
        }
        ATT_PACK(p0, p1);
#pragma unroll
        for (int db = 0; db < 4; ++db) {
            const s16x4 l0 = vtr(vb + db * 4096), h0 = vtr(vb + db * 4096 + 512), l1 = vtr(vb + db * 4096 + 1024), h1 = vtr(vb + db * 4096 + 1536);
            const s16x4 l2 = vtr(vb + db * 4096 + 2048), h2 = vtr(vb + db * 4096 + 2560), l3 = vtr(vb + db * 4096 + 3072), h3 = vtr(vb + db * 4096 + 3584);
            o[db] = __builtin_amdgcn_mfma_f32_32x32x16_bf16(__builtin_bit_cast(bf16x8, pw0), ATT_VFR(l0, h0), o[db], 0, 0, 0);
            o[db] = __builtin_amdgcn_mfma_f32_32x32x16_bf16(__builtin_bit_cast(bf16x8, pw1), ATT_VFR(l1, h1), o[db], 0, 0, 0);
            o[db] = __builtin_amdgcn_mfma_f32_32x32x16_bf16(__builtin_bit_cast(bf16x8, pw2), ATT_VFR(l2, h2), o[db], 0, 0, 0);
            o[db] = __builtin_amdgcn_mfma_f32_32x32x16_bf16(__builtin_bit_cast(bf16x8, pw3), ATT_VFR(l3, h3), o[db], 0, 0, 0);
        }
    }
    if (hi == 0) wsf[32 + r32] = l_reg;
    asm volatile("s_waitcnt lgkmcnt(0)" ::: "memory");
    bf16* stg = (bf16*)(shm + X_OST) + wid * 4096;
#pragma unroll
    for (int r = 0; r < 16; ++r) { const int orow = crow(r, hi); const float rl = __builtin_amdgcn_rcpf(wsf[32 + orow]);
#pragma unroll
        for (int db = 0; db < 4; ++db) stg[orow * 128 + db * 32 + r32] = (bf16)(cvt_pk_bf16(o[db][r] * rl, 0.f) & 0xffffu); }
    asm volatile("s_waitcnt lgkmcnt(0)" ::: "memory");
    bf16* Ow = OM + qrow0 * DM + h * 256 + dh * 128;
#pragma unroll
    for (int i = 0; i < 8; ++i) { const int row = i * 4 + (lane >> 4), ch = lane & 15; const u32x4 v = *(const u32x4*)(stg + row * 128 + ch * 8); *(u32x4*)(Ow + (long)row * DM + ch * 8) = v; }
    __syncthreads();
}
}

namespace ssd {
constexpr int PB = 288;
constexpr int PXD = 544;
constexpr int PXS = 160;
typedef short v4i16_t __attribute__((ext_vector_type(4)));
__device__ __forceinline__ s16x4 vtr(const char* p) { return __builtin_bit_cast(s16x4, __builtin_amdgcn_ds_read_tr16_b64_v4i16((LAS v4i16_t*)(unsigned)(uintptr_t)p)); }
#define SSD_FR(L, H) (bf16x8){L[0], L[1], L[2], L[3], H[0], H[1], H[2], H[3]}

struct ConvW { float w[4][8]; float b[8]; };
__device__ __forceinline__ void load_convw(ConvW& cw, const float* conv_w, const float* conv_b, int ch) {
#pragma unroll
    for (int k = 0; k < 4; ++k) { const f32x4 a = *(const f32x4*)(conv_w + k * 1024 + ch), c = *(const f32x4*)(conv_w + k * 1024 + ch + 4);
#pragma unroll
        for (int e = 0; e < 4; ++e) { cw.w[k][e] = a[e]; cw.w[k][4 + e] = c[e]; } }
    const f32x4 a = *(const f32x4*)(conv_b + ch), c = *(const f32x4*)(conv_b + ch + 4);
#pragma unroll
    for (int e = 0; e < 4; ++e) { cw.b[e] = a[e]; cw.b[4 + e] = c[e]; }
}
__device__ __forceinline__ void conv8(const bf16* PROJ, long grow, int spos, int ch, const ConvW& cw, float (&out)[8]) {
    float a[8];
#pragma unroll
    for (int e = 0; e < 8; ++e) a[e] = cw.b[e];
#pragma unroll
    for (int k = 0; k < 4; ++k) {
        if (spos - 3 + k >= 0) {
            const bf16x8 x = *(const bf16x8*)(PROJ + (grow - 3 + k) * NPROJ + PC_XBC + ch);
#pragma unroll
            for (int e = 0; e < 8; ++e) a[e] += cw.w[k][e] * bf2f((unsigned short)x[e]);
        }
    }
#pragma unroll
    for (int e = 0; e < 8; ++e) out[e] = silu_f(a[e]);
}
__device__ __forceinline__ u32x4 pack8(const float (&v)[8]) { u32x4 w; w.x = cvt_pk_bf16(v[0], v[1]); w.y = cvt_pk_bf16(v[2], v[3]); w.z = cvt_pk_bf16(v[4], v[5]); w.w = cvt_pk_bf16(v[6], v[7]); return w; }

__device__ __forceinline__ void chunk_acs(const float* DT, const float* a_log, long R0, int g, float* a_s, float* d_s) {
    const int tid = threadIdx.x, hh = tid >> 7, l = tid & 127, h = 4 * g + hh;
    const float dtv = DT[(R0 + l) * 8 + h];
    const float Ah = -__expf(a_log[h]);
    d_s[hh * 128 + l] = dtv * Ah;
    __syncthreads();
    float cs = 0.f;
    for (int i = 0; i <= l; ++i) cs += d_s[hh * 128 + i];
    a_s[hh * 128 + l] = cs;
    __syncthreads();
    d_s[hh * 128 + l] = dtv;
    __syncthreads();
}

constexpr int A_AS = 0, A_DS = 2048, A_BS = 4096, A_XD = A_BS + 128 * PB, A_BYTES = A_XD + 128 * PXD;
__device__ __forceinline__ void pass_a_unit(int unit, const bf16* PROJ, const float* DT, const float* a_log, const float* conv_w, const float* conv_b, float* ST, float* CD, char* shm) {
    const int tid = threadIdx.x, lane = tid & 63; const int wid = __builtin_amdgcn_readfirstlane(tid >> 6);
    const int g = unit & 1, c = (unit >> 1) & 31, b = unit >> 6;
    const long R0 = (long)b * SEQ + c * CHUNK;
    float* a_s = (float*)(shm + A_AS); float* d_s = (float*)(shm + A_DS);
    __syncthreads();
    chunk_acs(DT, a_log, R0, g, a_s, d_s);
    {
        const int hh = tid >> 7, l = tid & 127;
        const float tot = a_s[hh * 128 + 127], cs = a_s[hh * 128 + l], dtv = d_s[hh * 128 + l];
        __syncthreads();
        d_s[hh * 128 + l] = dtv * __expf(tot - cs);
        if (l == 127) CD[((long)b * NCHUNK + c) * 8 + 4 * g + hh] = __expf(tot);
    }
    __syncthreads();
    {
        const int o = tid & 31, ch = 256 * g + 8 * o, hh = o >> 3; ConvW cw; load_convw(cw, conv_w, conv_b, ch);
        for (int it = 0; it < 8; ++it) { const int l = it * 16 + (tid >> 5); float v[8]; conv8(PROJ, R0 + l, c * CHUNK + l, ch, cw, v);
            const float w = d_s[hh * 128 + l];
#pragma unroll
            for (int e = 0; e < 8; ++e) v[e] *= w;
            *(u32x4*)(shm + A_XD + l * PXD + o * 16) = pack8(v); }
    }
    {
        const int o = tid & 15, ch = 512 + 128 * g + 8 * o; ConvW cw; load_convw(cw, conv_w, conv_b, ch);
        for (int it = 0; it < 4; ++it) { const int l = it * 32 + (tid >> 4); float v[8]; conv8(PROJ, R0 + l, c * CHUNK + l, ch, cw, v);
            *(u32x4*)(shm + A_BS + l * PB + o * 16) = pack8(v); }
    }
    __syncthreads();
    const int hh = wid >> 1, nh = wid & 1, i16 = lane & 15, g4 = lane >> 4, q4 = (lane & 15) >> 2, p4 = lane & 3;
    f32x4 acc[4][4];
#pragma unroll
    for (int pt = 0; pt < 4; ++pt)
#pragma unroll
        for (int nt = 0; nt < 4; ++nt) acc[pt][nt] = (f32x4){0.f, 0.f, 0.f, 0.f};
#pragma unroll
    for (int ks = 0; ks < 4; ++ks) {
        const int rk = ks * 32 + 8 * g4 + q4;
        bf16x8 af[4], bfr[4];
#pragma unroll
        for (int pt = 0; pt < 4; ++pt) { const char* p = shm + A_XD + rk * PXD + (hh * 64 + pt * 16 + 4 * p4) * 2; const s16x4 lo = vtr(p), hi = vtr(p + 4 * PXD); af[pt] = SSD_FR(lo, hi); }
#pragma unroll
        for (int nt = 0; nt < 4; ++nt) { const char* p = shm + A_BS + rk * PB + (nh * 64 + nt * 16 + 4 * p4) * 2; const s16x4 lo = vtr(p), hi = vtr(p + 4 * PB); bfr[nt] = SSD_FR(lo, hi); }
#pragma unroll
        for (int pt = 0; pt < 4; ++pt)
#pragma unroll
            for (int nt = 0; nt < 4; ++nt) acc[pt][nt] = __builtin_amdgcn_mfma_f32_16x16x32_bf16(af[pt], bfr[nt], acc[pt][nt], 0, 0, 0);
    }
    float* dst = ST + ((((long)b * NCHUNK + c) * 8 + 4 * g + hh) * 64) * 128 + nh * 64 + i16;
#pragma unroll
    for (int pt = 0; pt < 4; ++pt)
#pragma unroll
        for (int nt = 0; nt < 4; ++nt)
#pragma unroll
            for (int r = 0; r < 4; ++r) dst[(long)(pt * 16 + 4 * g4 + r) * 128 + nt * 16] = acc[pt][nt][r];
}

constexpr int C_AS = 0, C_DS = 2048, C_CS = 4096, C_BS = C_CS + 128 * PB, C_MH = C_BS + 128 * PB, C_XS = C_MH + 128 * PB, C_BYTES = C_XS + 128 * PXS;
__device__ __forceinline__ void pass_c_unit(int unit, const bf16* PROJ, const float* DT, const float* a_log, const float* conv_w, const float* conv_b,
                                            const bf16* PREV, const float* d_skip, const float* norm_g, float* YT, bf16* YO, char* shm) {
    const int tid = threadIdx.x, lane = tid & 63; const int wid = __builtin_amdgcn_readfirstlane(tid >> 6);
    const int g = unit & 1, c = (unit >> 1) & 31, b = unit >> 6;
    const long R0 = (long)b * SEQ + c * CHUNK;
    float* a_s = (float*)(shm + C_AS); float* d_s = (float*)(shm + C_DS);
    const int i16 = lane & 15, g4 = lane >> 4, q4 = (lane & 15) >> 2, p4 = lane & 3;
    __syncthreads();
    chunk_acs(DT, a_log, R0, g, a_s, d_s);
    {
        const int o = tid & 15;
        { const int ch = 512 + 128 * g + 8 * o; ConvW cw; load_convw(cw, conv_w, conv_b, ch);
          for (int it = 0; it < 4; ++it) { const int l = it * 32 + (tid >> 4); float v[8]; conv8(PROJ, R0 + l, c * CHUNK + l, ch, cw, v); *(u32x4*)(shm + C_BS + l * PB + o * 16) = pack8(v); } }
        { const int ch = 768 + 128 * g + 8 * o; ConvW cw; load_convw(cw, conv_w, conv_b, ch);
          for (int it = 0; it < 4; ++it) { const int l = it * 32 + (tid >> 4); float v[8]; conv8(PROJ, R0 + l, c * CHUNK + l, ch, cw, v); *(u32x4*)(shm + C_CS + l * PB + o * 16) = pack8(v); } }
    }
    __syncthreads();
    float ss[4] = {0.f, 0.f, 0.f, 0.f};
#pragma unroll 1
    for (int hh = 0; hh < 4; ++hh) {
        const int h = 4 * g + hh;
        {
            const int o = tid & 7, ch = 256 * g + 64 * hh + 8 * o; ConvW cw; load_convw(cw, conv_w, conv_b, ch);
            for (int it = 0; it < 2; ++it) { const int l = it * 64 + (tid >> 3); float v[8]; conv8(PROJ, R0 + l, c * CHUNK + l, ch, cw, v); *(u32x4*)(shm + C_XS + l * PXS + o * 16) = pack8(v); }
        }
        {
            bf16x8 cfr[4];
#pragma unroll
            for (int ks = 0; ks < 4; ++ks) cfr[ks] = *(const bf16x8*)(shm + C_CS + (16 * wid + i16) * PB + (ks * 32 + 8 * g4) * 2);
            float al[4];
#pragma unroll
            for (int r = 0; r < 4; ++r) al[r] = a_s[hh * 128 + 16 * wid + 4 * g4 + r];
#pragma unroll
            for (int st = 0; st < 8; ++st) {
                f32x4 cb = (f32x4){0.f, 0.f, 0.f, 0.f};
#pragma unroll
                for (int ks = 0; ks < 4; ++ks) { const bf16x8 bfr = *(const bf16x8*)(shm + C_BS + (16 * st + i16) * PB + (ks * 32 + 8 * g4) * 2);
                    cb = __builtin_amdgcn_mfma_f32_16x16x32_bf16(cfr[ks], bfr, cb, 0, 0, 0); }
                const int s = 16 * st + i16; const float as_ = a_s[hh * 128 + s], ds_ = d_s[hh * 128 + s];
#pragma unroll
                for (int r = 0; r < 4; ++r) { const int l = 16 * wid + 4 * g4 + r;
                    const float v = (s <= l) ? cb[r] * __expf(al[r] - as_) * ds_ : 0.f;
                    *(bf16*)(shm + C_MH + l * PB + s * 2) = (bf16)(cvt_pk_bf16(v, 0.f) & 0xffffu); }
            }
        }
        __syncthreads();
        f32x4 yd[4], yo[4];
#pragma unroll
        for (int pt = 0; pt < 4; ++pt) { yd[pt] = (f32x4){0.f, 0.f, 0.f, 0.f}; yo[pt] = (f32x4){0.f, 0.f, 0.f, 0.f}; }
        const bf16* prev_h = PREV + ((((long)b * NCHUNK + c) * 8 + h) * 64) * 128;
#pragma unroll
        for (int ks = 0; ks < 4; ++ks) {
            const bf16x8 mfr = *(const bf16x8*)(shm + C_MH + (16 * wid + i16) * PB + (ks * 32 + 8 * g4) * 2);
            const bf16x8 cf = *(const bf16x8*)(shm + C_CS + (16 * wid + i16) * PB + (ks * 32 + 8 * g4) * 2);
            const int rk = ks * 32 + 8 * g4 + q4;
#pragma unroll
            for (int pt = 0; pt < 4; ++pt) {
                const char* p = shm + C_XS + rk * PXS + (pt * 16 + 4 * p4) * 2; const s16x4 lo = vtr(p), hi = vtr(p + 4 * PXS);
                yd[pt] = __builtin_amdgcn_mfma_f32_16x16x32_bf16(mfr, SSD_FR(lo, hi), yd[pt], 0, 0, 0);
                const bf16x8 pf = *(const bf16x8*)(prev_h + (long)(pt * 16 + i16) * 128 + ks * 32 + 8 * g4);
                yo[pt] = __builtin_amdgcn_mfma_f32_16x16x32_bf16(cf, pf, yo[pt], 0, 0, 0);
            }
        }
        const float Dh = d_skip[h];
#pragma unroll
        for (int r = 0; r < 4; ++r) { const int l = 16 * wid + 4 * g4 + r; const float ea = __expf(a_s[hh * 128 + l]);
#pragma unroll
            for (int pt = 0; pt < 4; ++pt) { const int p = pt * 16 + i16;
                const float xs = bf2f(*(const bf16*)(shm + C_XS + l * PXS + p * 2));
                const float z = bf2f(PROJ[(R0 + l) * NPROJ + PC_Z + 64 * h + p]);
                float y = yd[pt][r] + ea * yo[pt][r] + xs * Dh;
                y *= silu_f(z);
                YT[(R0 + l) * 512 + 64 * h + p] = y; ss[r] += y * y; } }
        __syncthreads();
    }
#pragma unroll
    for (int r = 0; r < 4; ++r) { float s = ss[r]; s += __shfl_xor(s, 1); s += __shfl_xor(s, 2); s += __shfl_xor(s, 4); s += __shfl_xor(s, 8); ss[r] = __builtin_amdgcn_rsqf(s * (1.f / 256.f) + RMS_EPS); }
#pragma unroll 1
    for (int hh = 0; hh < 4; ++hh)
#pragma unroll
        for (int pt = 0; pt < 4; ++pt) { const int ch = 256 * g + 64 * hh + pt * 16 + i16; const float ng = norm_g[ch];
#pragma unroll
            for (int r = 0; r < 4; ++r) { const int l = 16 * wid + 4 * g4 + r;
                const float y = YT[(R0 + l) * 512 + ch];
                YO[(R0 + l) * DM + ch] = (bf16)(cvt_pk_bf16(y * ss[r] * ng, 0.f) & 0xffffu); } }
}
}

constexpr size_t MiB = 1u << 20;
constexpr size_t WS_CTL = 0, CTL_ZERO_BYTES = 1 * MiB;
constexpr size_t WS_STATS = 1 * MiB;
constexpr size_t WS_CD = WS_STATS + 3 * (size_t)M * 2 * 4;
constexpr size_t WS_WIN = 2 * MiB;
constexpr size_t WS_WQ = WS_WIN + (size_t)NPROJ * DM * 2;
constexpr size_t WS_WKV = WS_WQ + (size_t)NQ * 384 * 2;
constexpr size_t WS_WMIX = WS_WKV + (size_t)NKV * 256 * 2;
constexpr size_t WS_WMQ = WS_WMIX + 2 * MiB;
constexpr size_t WS_WMKV = WS_WMQ + 2 * MiB;
constexpr size_t WS_WMO = WS_WMKV + 4 * MiB;
constexpr size_t WS_WUP = WS_WMO + 2 * MiB;
constexpr size_t WS_WDN = WS_WUP + 8 * MiB;
constexpr size_t WS_WEND = WS_WDN + 8 * MiB;
static_assert(WS_WEND <= 34 * MiB, "weights");
constexpr size_t WS_MEMB = 34 * MiB, WS_KM = 38 * MiB, WS_VM = 42 * MiB;
constexpr size_t WS_KPE = 46 * MiB;
constexpr size_t WS_COS = 48 * MiB, WS_SIN = 50 * MiB;
constexpr size_t WS_DT = 52 * MiB;
constexpr size_t WS_SSQ = 53 * MiB;
constexpr size_t WS_XN = 56 * MiB;
constexpr size_t WS_YO = WS_XN;
constexpr size_t WS_U2 = 120 * MiB;
constexpr size_t WS_Q = 120 * MiB, WS_KV = 168 * MiB;
constexpr size_t WS_HB = 248 * MiB;
constexpr size_t WS_PROJ = 248 * MiB;
constexpr size_t WS_ST = 392 * MiB;
constexpr size_t WS_PREV = 456 * MiB;
constexpr size_t WS_QM = 248 * MiB, WS_OM = 312 * MiB;
constexpr size_t WS_END = 504 * MiB;
static_assert(WS_KV + (size_t)M * NKV * 2 <= WS_HB && WS_PREV + 32 * MiB <= WS_END && WS_SSQ + (size_t)M * 24 * 4 <= WS_XN, "d_ws map");

typedef GAS unsigned gu32;
#define RLX_AGENT __ATOMIC_RELAXED, __HIP_MEMORY_SCOPE_AGENT
#define XB_TMO      128
#define XB_XCNT(j)  (256  + 64 * (j))
#define XB_XSUB(j)  (1280 + 64 * (j))
#define XB_XGEN(j)  (2304 + 64 * (j))
#define XB_TOP      3328
#define XB_TOPGEN   3392
#define XCD_BAR_WORDS 3456
#define XB_SPIN_CAP (1u << 18)
__device__ __forceinline__ unsigned xb_ld(unsigned* p)              { return __hip_atomic_load(p, __ATOMIC_RELAXED, __HIP_MEMORY_SCOPE_AGENT); }
__device__ __forceinline__ unsigned xb_add(unsigned* p, unsigned v) { return __hip_atomic_fetch_add(p, v, __ATOMIC_RELAXED, __HIP_MEMORY_SCOPE_AGENT); }
__device__ __forceinline__ unsigned xb_xcc_id() { return (unsigned)__builtin_amdgcn_s_getreg((3 << 11) | 20) & 0xFu; }
#define XB_SPIN(cond, bar) do { unsigned _sp = 0; while (cond) { __builtin_amdgcn_s_sleep(1); \
    if ((++_sp & 255u) == 0u) { if (xb_ld(&(bar)[XB_TMO])) break; if (_sp > XB_SPIN_CAP) { atomicAdd(&(bar)[XB_TMO], 1u); break; } } } } while (0)
struct XcdBarrier { unsigned* bar; unsigned x; volatile LAS unsigned* st; };
__device__ __forceinline__ XcdBarrier xcd_barrier_post(unsigned* bar, volatile LAS unsigned* st) {
    XcdBarrier b; b.bar = bar; b.x = xb_xcc_id(); b.st = st;
    if (threadIdx.x == 0) (void)xb_add(&bar[XB_XCNT(b.x)], 1u);
    return b;
}
__device__ __forceinline__ void xcd_barrier_complete(unsigned* bar, unsigned x, unsigned& nloc, unsigned& nx) {
    const unsigned G = gridDim.x * gridDim.y * gridDim.z;
    unsigned sum, cnt, mine, sp = 0u;
    for (;;) {
        sum = 0u; cnt = 0u; mine = 0u;
#pragma unroll
        for (unsigned j = 0; j < 16; ++j) { const unsigned c = xb_ld(&bar[XB_XCNT(j)]); sum += c; cnt += (c > 0u) ? 1u : 0u; mine = (j == x) ? c : mine; }
        if (sum == G) break;
        __builtin_amdgcn_s_sleep(1);
        if ((++sp & 255u) == 0u) { if (xb_ld(&bar[XB_TMO])) break; if (sp > XB_SPIN_CAP) { atomicAdd(&bar[XB_TMO], 1u); break; } }
    }
    nloc = mine > 0u ? mine : 1u; nx = cnt > 0u ? cnt : 1u;
}
__device__ __forceinline__ void xcd_barrier(const XcdBarrier& b) {
    asm volatile("s_waitcnt vmcnt(0)" ::: "memory");
    __syncthreads();
    if (threadIdx.x == 0) {
        unsigned* bar = b.bar;
        __builtin_amdgcn_s_waitcnt(0);
        unsigned nloc = b.st[0], nx = b.st[1];
        if (nloc == 0u) { xcd_barrier_complete(bar, b.x, nloc, nx); b.st[0] = nloc; b.st[1] = nx; }
        const unsigned old = xb_add(&bar[XB_XSUB(b.x)], 1u);
        const unsigned gen = old / nloc;
        if (old + 1u == (gen + 1u) * nloc) {
            __builtin_amdgcn_fence(__ATOMIC_RELEASE, "agent");
            asm volatile("s_waitcnt vmcnt(0)" ::: "memory");
            const unsigned og = xb_add(&bar[XB_TOP], 1u);
            const unsigned tg = og / nx;
            if (og + 1u == (tg + 1u) * nx) xb_add(&bar[XB_TOPGEN], 1u);
            else XB_SPIN(xb_ld(&bar[XB_TOPGEN]) == tg, bar);
            __builtin_amdgcn_fence(__ATOMIC_ACQUIRE, "agent");
            xb_add(&bar[XB_XGEN(b.x)], 1u);
            asm volatile("s_waitcnt vmcnt(0)" ::: "memory");
        } else {
            XB_SPIN(xb_ld(&bar[XB_XGEN(b.x)]) == gen, bar);
            __builtin_amdgcn_fence(__ATOMIC_ACQUIRE, "agent");
            asm volatile("s_waitcnt vmcnt(0)" ::: "memory");
        }
    }
    __syncthreads();
}

constexpr int NWAVES = 8;
constexpr int RING_OFF = 0, RING_BYTES = 135168;
constexpr int LDSCTL_OFF = RING_BYTES, MISC_OFF = LDSCTL_OFF + 320;
constexpr int LDS_BYTES = 147456;
static_assert(att::S_BYTES <= RING_BYTES && att::X_BYTES <= RING_BYTES && pg8::STAGE_BYTES <= RING_BYTES && MISC_OFF + 128 <= LDS_BYTES, "LDS map");
static_assert(ssd::A_BYTES <= RING_BYTES && ssd::C_BYTES <= RING_BYTES, "SSD scratch");

__device__ __forceinline__ float wave_sum(float v) {
#pragma unroll
    for (int o = 1; o < 64; o <<= 1) v += __shfl_xor(v, o);
    return v;
}
enum { WM_ID = 0, WM_IN = 1, WM_Q = 2, WM_KV = 3 };
__device__ __forceinline__ int srccol(int kind, int n) {
    if (kind == WM_IN) {
        if (n < PC_KR) return n < PC_QL ? n : n + 8;
        if (n < PC_DT) { const int i = n - PC_KR; return 2184 + (i >> 1) + 16 * (i & 1); }
        if (n < PC_DT + 8) return 1536 + (n - PC_DT);
        return -1;
    }
    if (kind == WM_Q) { const int h = n / 96, d = n % 96; if (d < 64) return n; const int i = d - 64; return h * 96 + 64 + (i >> 1) + 16 * (i & 1); }
    if (kind == WM_KV) { if (n < 512) return (n >> 6) * 128 + (n & 63); const int n2 = n - 512; return (n2 >> 6) * 128 + 64 + (n2 & 63); }
    return n;
}
__device__ __forceinline__ void transpose_item(const float* W, int K, int Nsrc, int Ndst, bf16* WT, int row_off, int kind, const float* rowscale, float cscale, LAS float* scr, int item, int lane) {
    const int nblk = Ndst / 32, kb = item / nblk, nb = item % nblk, k0 = 64 * kb, n0 = 32 * nb;
    const int sc = srccol(kind, n0 + (lane & 31));
#pragma unroll 8
    for (int i = 0; i < 32; ++i) { const int kk = 2 * i + (lane >> 5);
        float v = 0.f; if (sc >= 0) { v = W[(size_t)(k0 + kk) * Nsrc + sc] * cscale; if (rowscale) v *= rowscale[k0 + kk]; }
        scr[kk * 33 + (lane & 31)] = v; }
    asm volatile("s_waitcnt lgkmcnt(0)" ::: "memory");
    const int c = lane & 7;
#pragma unroll
    for (int j = 0; j < 4; ++j) { const int n = (lane >> 3) + 8 * j; const LAS float* s = scr + (8 * c) * 33 + n;
        u32x4 o; o.x = cvt_pk_bf16(s[0 * 33], s[1 * 33]); o.y = cvt_pk_bf16(s[2 * 33], s[3 * 33]); o.z = cvt_pk_bf16(s[4 * 33], s[5 * 33]); o.w = cvt_pk_bf16(s[6 * 33], s[7 * 33]);
        *(u32x4*)(WT + (size_t)(row_off + n0 + n) * K + k0 + 8 * c) = o; }
    asm volatile("s_waitcnt lgkmcnt(0)" ::: "memory");
}
__device__ __forceinline__ void ln_row(const float* urow, const float* g, const float* b, float* stats, bf16* xn, float* fo, int lane) {
    const f32x4* xr = (const f32x4*)urow + lane;
    f32x4 v[4]; float s = 0.f;
#pragma unroll
    for (int j = 0; j < 4; ++j) { v[j] = xr[64 * j]; s += (v[j][0] + v[j][1]) + (v[j][2] + v[j][3]); }
    const float mean = wave_sum(s) * (1.f / DM); float s2 = 0.f;
#pragma unroll
    for (int j = 0; j < 4; ++j) { v[j] = v[j] - mean; s2 += (v[j][0] * v[j][0] + v[j][1] * v[j][1]) + (v[j][2] * v[j][2] + v[j][3] * v[j][3]); }
    const float rstd = 1.f / sqrtf(wave_sum(s2) * (1.f / DM) + LN_EPS);
    if (stats && lane == 0) { stats[0] = mean; stats[1] = rstd; }
#pragma unroll
    for (int j = 0; j < 4; ++j) {
        const f32x4 gg = *((const f32x4*)g + lane + 64 * j), bb = *((const f32x4*)b + lane + 64 * j);
        const f32x4 y = v[j] * rstd * gg + bb;
        if (xn) { u32x2 w; w.x = cvt_pk_bf16(y[0], y[1]); w.y = cvt_pk_bf16(y[2], y[3]); *((u32x2*)xn + lane + 64 * j) = w; }
        if (fo) *((f32x4*)fo + lane + 64 * j) = y;
    }
}

enum { PH_PRO = 0, PH_INPROJ, PH_UP, PH_ATTN, PH_SSDC, PH_MIX, PH_LN1, PH_MEMQ, PH_XATT, PH_MEMO, PH_LN2, PH_FFUP, PH_FFDN, PH_LN3, NPH };
struct Args { const void* in[29]; float* out; unsigned char* ws; int ph_lo, ph_hi; };
static_assert(sizeof(Args) == 29 * 8 + 8 + 8 + 8, "Args has no padding");


#define INF(i) ((const float*)args.in[i])
#define x_        INF(0)
#define mem_      INF(1)
#define positions_ ((const int*)args.in[2])
#define ln_in_g   INF(3)
#define ln_in_b   INF(4)
#define w_in      INF(5)
#define conv_w    INF(6)
#define conv_b    INF(7)
#define dt_bias   INF(8)
#define a_log     INF(9)
#define d_skip    INF(10)
#define ssd_norm_g INF(11)
#define q_norm_g  INF(12)
#define w_q_up    INF(13)
#define kv_norm_g INF(14)
#define w_kv_up   INF(15)
#define w_mix_out INF(16)
#define ln1_g     INF(17)
#define ln1_b     INF(18)
#define w_mem_q   INF(19)
#define w_mem_k   INF(20)
#define w_mem_v   INF(21)
#define w_mem_o   INF(22)
#define ln2_g     INF(23)
#define ln2_b     INF(24)
#define w_up      INF(25)
#define w_down    INF(26)
#define ln3_g     INF(27)
#define ln3_b     INF(28)
#define WSP(T, off) ((T*)(args.ws + (off)))
#define STATS  WSP(float, WS_STATS)
#define CD     WSP(float, WS_CD)
#define Win_t  WSP(bf16, WS_WIN)
#define Wq_t   WSP(bf16, WS_WQ)
#define Wkv_t  WSP(bf16, WS_WKV)
#define Wmix_t WSP(bf16, WS_WMIX)
#define Wmq_t  WSP(bf16, WS_WMQ)
#define Wmkv_t WSP(bf16, WS_WMKV)
#define Wmo_t  WSP(bf16, WS_WMO)
#define Wup_t  WSP(bf16, WS_WUP)
#define Wdn_t  WSP(bf16, WS_WDN)
#define MEMB   WSP(bf16, WS_MEMB)
#define KM     WSP(bf16, WS_KM)
#define VM     WSP(bf16, WS_VM)
#define KPE    WSP(bf16, WS_KPE)
#define COS    WSP(float, WS_COS)
#define SIN    WSP(float, WS_SIN)
#define DT     WSP(float, WS_DT)
#define SSQ    WSP(float, WS_SSQ)
#define XN     WSP(bf16, WS_XN)
#define YO     WSP(bf16, WS_YO)
#define U2     WSP(float, WS_U2)
#define Qb     WSP(bf16, WS_Q)
#define KVb    WSP(bf16, WS_KV)
#define HB     WSP(bf16, WS_HB)
#define PROJ   WSP(bf16, WS_PROJ)
#define ST     WSP(float, WS_ST)
#define PREV   WSP(bf16, WS_PREV)
#define QM     WSP(bf16, WS_QM)
#define OM     WSP(bf16, WS_OM)
#define U1     (args.out)
#define OUT    (args.out)
__global__ void __launch_bounds__(NWAVES * 64, 2) layer_fwd(Args args) {
    extern __shared__ __attribute__((aligned(16))) unsigned char lds[];
    LAS unsigned char* ldsl = (LAS unsigned char*)lds;
    volatile LAS unsigned* MISC = (volatile LAS unsigned*)(ldsl + MISC_OFF);
    const int tid = threadIdx.x, lane = tid & 63, wave = __builtin_amdgcn_readfirstlane(tid >> 6);
    const int G = gridDim.x; const int bx = blockIdx.x; const int vcu = (G % 8 == 0) ? (bx % 8) * (G / 8) + bx / 8 : bx;
    gu32* ctl = (gu32*)(args.ws + WS_CTL);
    for (int u = tid; u < (LDS_BYTES - LDSCTL_OFF) / 4; u += NWAVES * 64) ((LAS unsigned*)(ldsl + LDSCTL_OFF))[u] = 0u;
    __syncthreads();
    const int lo = args.ph_lo, hi = args.ph_hi;
    const bool one_launch = (hi - lo) > 1;
    XcdBarrier bar; bar.bar = (unsigned*)(ctl + 4096); bar.x = 0; bar.st = nullptr;
    if (one_launch) bar = xcd_barrier_post((unsigned*)(ctl + 4096), MISC + 8);
#define IN(k) (lo <= (k) && (k) < hi)
#define SEAM(k) do { if (IN(k) && IN((k) + 1)) xcd_barrier(bar); } while (0)
    const int gw = vcu * NWAVES + wave, NGW = G * NWAVES;
    const int gt = vcu * (NWAVES * 64) + tid, NGT = G * NWAVES * 64;

    if (IN(PH_PRO)) {
        LAS float* scr = (LAS float*)(ldsl + RING_OFF + wave * 16384);
        constexpr int I_IN = (DM / 64) * (NPROJ / 32), I_Q = (384 / 64) * (NQ / 32), I_KV = (256 / 64) * (NKV / 32), I_SQ = (DM / 64) * (DM / 32), I_UP = (DM / 64) * (FF / 32), I_DN = (FF / 64) * (DM / 32);
        constexpr int NITEMS = I_IN + I_Q + I_KV + 5 * I_SQ + I_UP + I_DN;
        for (int it = gw; it < NITEMS; it += NGW) {
            int r = it;
            if (r < I_IN) { transpose_item(w_in, DM, 2216, NPROJ, Win_t, 0, WM_IN, nullptr, 1.f, scr, r, lane); continue; } r -= I_IN;
            if (r < I_Q) { transpose_item(w_q_up, 384, NQ, NQ, Wq_t, 0, WM_Q, q_norm_g, QSCALE, scr, r, lane); continue; } r -= I_Q;
            if (r < I_KV) { transpose_item(w_kv_up, 256, NKV, NKV, Wkv_t, 0, WM_KV, kv_norm_g, 1.f, scr, r, lane); continue; } r -= I_KV;
            if (r < I_SQ) { transpose_item(w_mix_out, DM, DM, DM, Wmix_t, 0, WM_ID, nullptr, 1.f, scr, r, lane); continue; } r -= I_SQ;
            if (r < I_SQ) { transpose_item(w_mem_q, DM, DM, DM, Wmq_t, 0, WM_ID, nullptr, MSCALE, scr, r, lane); continue; } r -= I_SQ;
            if (r < I_SQ) { transpose_item(w_mem_k, DM, DM, DM, Wmkv_t, 0, WM_ID, nullptr, 1.f, scr, r, lane); continue; } r -= I_SQ;
            if (r < I_SQ) { transpose_item(w_mem_v, DM, DM, DM, Wmkv_t, DM, WM_ID, nullptr, 1.f, scr, r, lane); continue; } r -= I_SQ;
            if (r < I_SQ) { transpose_item(w_mem_o, DM, DM, DM, Wmo_t, 0, WM_ID, nullptr, 1.f, scr, r, lane); continue; } r -= I_SQ;
            if (r < I_UP) { transpose_item(w_up, DM, FF, FF, Wup_t, 0, WM_ID, nullptr, 1.f, scr, r, lane); continue; } r -= I_UP;
            transpose_item(w_down, FF, DM, DM, Wdn_t, 0, WM_ID, nullptr, 1.f, scr, r, lane);
        }
        for (int i = gt; i < BATCH * MEMT * DM / 8; i += NGT) {
            const f32x4 a = *((const f32x4*)mem_ + 2 * (size_t)i), b = *((const f32x4*)mem_ + 2 * (size_t)i + 1);
            u32x4 w; w.x = cvt_pk_bf16(a[0], a[1]); w.y = cvt_pk_bf16(a[2], a[3]); w.z = cvt_pk_bf16(b[0], b[1]); w.w = cvt_pk_bf16(b[2], b[3]);
            *((u32x4*)MEMB + i) = w;
        }
        for (int i = gt; i < M * 16; i += NGT) {
            const int row = i >> 4, j = i & 15;
            const float invf = exp2f(-(float)j * (13.287712379549449f / 16.f));
            const float ang = (float)positions_[row] * invf;
            COS[i] = (float)cos((double)ang); SIN[i] = (float)sin((double)ang);
        }
        for (int m = gw; m < M; m += NGW) ln_row(x_ + (size_t)m * DM, ln_in_g, ln_in_b, STATS + (size_t)m * 2, XN + (size_t)m * DM, nullptr, lane);
    }
    SEAM(PH_PRO);

    if (IN(PH_INPROJ)) {
        pg8::Gemm g{XN, Win_t, M, NPROJ, DM, DM, DM}; pg8::StaticOrder S; S.init(M, NPROJ, G, bx);
        pg8::EpiP E{pg8::EK_PROJ, PROJ, NPROJ, SSQ, DT, dt_bias, nullptr, nullptr, nullptr, 0, 0};
        pg8::gemm_phase<pg8::EpiP, pg8::StaticOrder, true, true>(ldsl + RING_OFF, g, S, E);
    }
    SEAM(PH_INPROJ);

    if (IN(PH_UP)) {
        for (int i = gt; i < M * 4; i += NGT) {
            const int row = i >> 2, o8 = i & 3;
            const bf16x8 xv = *(const bf16x8*)(PROJ + (size_t)row * NPROJ + PC_KR + 8 * o8);
            const f32x4 cs = *(const f32x4*)(COS + (size_t)row * 16 + 4 * o8), sn = *(const f32x4*)(SIN + (size_t)row * 16 + 4 * o8);
            float v[8];
#pragma unroll
            for (int j = 0; j < 4; ++j) { const float x1 = bf2f((unsigned short)xv[2 * j]), x2 = bf2f((unsigned short)xv[2 * j + 1]); v[2 * j] = x1 * cs[j] - x2 * sn[j]; v[2 * j + 1] = x2 * cs[j] + x1 * sn[j]; }
            u32x4 w; w.x = cvt_pk_bf16(v[0], v[1]); w.y = cvt_pk_bf16(v[2], v[3]); w.z = cvt_pk_bf16(v[4], v[5]); w.w = cvt_pk_bf16(v[6], v[7]);
            *(u32x4*)(KPE + (size_t)row * 32 + 8 * o8) = w;
        }
        __syncthreads();
        { pg8::Gemm g{PROJ + PC_QL, Wq_t, M, NQ, 384, NPROJ, 384}; pg8::StaticOrder S; S.init(M, NQ, G, bx);
          pg8::EpiP E{pg8::EK_QUP, Qb, NQ, nullptr, nullptr, nullptr, SSQ, COS, SIN, 0, 0};
          pg8::gemm_phase<pg8::EpiP, pg8::StaticOrder, true, true>(ldsl + RING_OFF, g, S, E); }
        __syncthreads();
        { pg8::Gemm g{PROJ + PC_KVL, Wkv_t, M, NKV, 256, NPROJ, 256}; pg8::StaticOrder S; S.init(M, NKV, G, bx);
          pg8::EpiP E{pg8::EK_KVUP, KVb, NKV, nullptr, nullptr, nullptr, SSQ, nullptr, nullptr, 0, 0};
          pg8::gemm_phase<pg8::EpiP, pg8::StaticOrder, true, true>(ldsl + RING_OFF, g, S, E); }
        __syncthreads();
        { pg8::Gemm g{MEMB, Wmkv_t, BATCH * MEMT, 2 * DM, DM, DM, DM}; pg8::StaticOrder S; S.init(BATCH * MEMT, 2 * DM, G, bx);
          pg8::EpiP E{pg8::EK_PLAIN, KM, DM, nullptr, nullptr, nullptr, nullptr, nullptr, nullptr, DM, (long)((WS_VM - WS_KM) / 2)};
          pg8::gemm_phase<pg8::EpiP, pg8::StaticOrder, true, true>(ldsl + RING_OFF, g, S, E); }
        __syncthreads();
        for (int u = vcu; u < BATCH * NCHUNK * 2; u += G) ssd::pass_a_unit(u, PROJ, DT, a_log, conv_w, conv_b, ST, CD, (char*)lds + RING_OFF);
    }
    SEAM(PH_UP);

    if (IN(PH_ATTN)) {
        for (int id = gt; id < BATCH * 8 * 8192; id += NGT) {
            const int bh = id >> 13, e = id & 8191, b = bh >> 3, h = bh & 7;
            float st = 0.f;
            for (int c = 0; c < NCHUNK; ++c) {
                const size_t idx = ((((size_t)b * NCHUNK + c) * 8 + h) << 13) + e;
                PREV[idx] = (bf16)(cvt_pk_bf16(st, 0.f) & 0xffffu);
                st = st * CD[((size_t)b * NCHUNK + c) * 8 + h] + ST[idx];
            }
        }
        __syncthreads();
        if (G == 256) {
            for (int i = 0; i < 4; ++i) {
                const int s = vcu & 3, bh = vcu >> 2;
                const int qb = (i == 0) ? 15 - s : (i == 1) ? 8 + s : (i == 2) ? 7 - s : s;
                att::self_unit(bh >> 3, bh & 7, qb, Qb, KVb, KPE, YO, (char*)lds + RING_OFF);
            }
        } else {
            for (int u = vcu; u < BATCH * 8 * 16; u += G) att::self_unit(u >> 7, (u >> 4) & 7, u & 15, Qb, KVb, KPE, YO, (char*)lds + RING_OFF);
        }
    }
    SEAM(PH_ATTN);

    if (IN(PH_SSDC)) {
        for (int u = vcu; u < BATCH * NCHUNK * 2; u += G) ssd::pass_c_unit(u, PROJ, DT, a_log, conv_w, conv_b, PREV, d_skip, ssd_norm_g, ST  , YO, (char*)lds + RING_OFF);
    }
    SEAM(PH_SSDC);

    if (IN(PH_MIX)) {
        pg8::Gemm g{YO, Wmix_t, M, DM, DM, DM, DM}; pg8::StaticOrder S; S.init(M, DM, G, bx);
        pg8::EpiR E{x_, STATS, ln_in_g, ln_in_b, U1};
        pg8::gemm_phase<pg8::EpiR, pg8::StaticOrder, true, true>(ldsl + RING_OFF, g, S, E);
    }
    SEAM(PH_MIX);
    if (IN(PH_LN1)) { for (int m = gw; m < M; m += NGW) ln_row(U1 + (size_t)m * DM, ln1_g, ln1_b, STATS + (size_t)M * 2 + (size_t)m * 2, XN + (size_t)m * DM, nullptr, lane); }
    SEAM(PH_LN1);

    if (IN(PH_MEMQ)) {
        pg8::Gemm g{XN, Wmq_t, M, DM, DM, DM, DM}; pg8::StaticOrder S; S.init(M, DM, G, bx);
        pg8::EpiP E{pg8::EK_PLAIN, QM, DM, nullptr, nullptr, nullptr, nullptr, nullptr, nullptr, 0, 0};
        pg8::gemm_phase<pg8::EpiP, pg8::StaticOrder, true, true>(ldsl + RING_OFF, g, S, E);
    }
    SEAM(PH_MEMQ);

    if (IN(PH_XATT)) {
        for (int u = vcu; u < BATCH * 4 * (SEQ / 128); u += G) {
            const int qt = u & 31, bh = u >> 5;
            att::cross_unit(bh >> 2, bh & 3, qt, QM, KM, VM, OM, (char*)lds + RING_OFF);
        }
    }
    SEAM(PH_XATT);

    if (IN(PH_MEMO)) {
        pg8::Gemm g{OM, Wmo_t, M, DM, DM, DM, DM}; pg8::StaticOrder S; S.init(M, DM, G, bx);
        pg8::EpiR E{U1, STATS + (size_t)M * 2, ln1_g, ln1_b, U2};
        pg8::gemm_phase<pg8::EpiR, pg8::StaticOrder, true, true>(ldsl + RING_OFF, g, S, E);
    }
    SEAM(PH_MEMO);
    if (IN(PH_LN2)) { for (int m = gw; m < M; m += NGW) ln_row(U2 + (size_t)m * DM, ln2_g, ln2_b, STATS + (size_t)M * 4 + (size_t)m * 2, XN + (size_t)m * DM, nullptr, lane); }
    SEAM(PH_LN2);

    if (IN(PH_FFUP)) {
        pg8::Gemm g{XN, Wup_t, M, FF, DM, DM, DM}; pg8::StaticOrder S; S.init(M, FF, G, bx);
        pg8::EpiP E{pg8::EK_SQRELU, HB, FF, nullptr, nullptr, nullptr, nullptr, nullptr, nullptr, 0, 0};
        pg8::gemm_phase<pg8::EpiP, pg8::StaticOrder, true, true>(ldsl + RING_OFF, g, S, E);
    }
    SEAM(PH_FFUP);

    if (IN(PH_FFDN)) {
        pg8::Gemm g{HB, Wdn_t, M, DM, FF, FF, FF}; pg8::StaticOrder S; S.init(M, DM, G, bx);
        pg8::EpiR E{U2, STATS + (size_t)M * 4, ln2_g, ln2_b, OUT};
        pg8::gemm_phase<pg8::EpiR, pg8::StaticOrder, true, true>(ldsl + RING_OFF, g, S, E);
    }
    SEAM(PH_FFDN);
    if (IN(PH_LN3)) { for (int m = gw; m < M; m += NGW) ln_row(OUT + (size_t)m * DM, ln3_g, ln3_b, nullptr, nullptr, OUT + (size_t)m * DM, lane); }
#undef IN
#undef SEAM
}

extern "C" void kernel_launch(void* const* d_in, const int* in_sizes, int n_in, void* d_out, int out_size, void* d_ws, size_t ws_size, hipStream_t stream) {
    static int grid = 0;
    if (grid == 0) {
        if (n_in != 29 || in_sizes[0] != M * DM || out_size != M * DM || ws_size < WS_END) {
            fprintf(stderr, "kernel_launch: unexpected shapes: n_in %d in0 %d out %d ws %zu (need >= %zu)\n", n_in, n_in > 0 ? in_sizes[0] : -1, out_size, ws_size, (size_t)WS_END); grid = -1; return; }
        int dev = 0, cus = 0;
        if (hipGetDevice(&dev) != hipSuccess || hipDeviceGetAttribute(&cus, hipDeviceAttributeMultiprocessorCount, dev) != hipSuccess) { fprintf(stderr, "kernel_launch: device query failed\n"); grid = -1; return; }
        if (hipFuncSetAttribute((const void*)layer_fwd, hipFuncAttributeMaxDynamicSharedMemorySize, LDS_BYTES) != hipSuccess) { fprintf(stderr, "kernel_launch: hipFuncSetAttribute failed\n"); grid = -1; return; }
        (void)hipGetLastError();
        grid = cus;
    }
    if (grid < 0) return;
    if (hipMemsetAsync((char*)d_ws + WS_CTL, 0, CTL_ZERO_BYTES, stream) != hipSuccess) { fprintf(stderr, "kernel_launch: memset failed\n"); return; }
    Args a{};
    for (int i = 0; i < 29; ++i) a.in[i] = d_in[i];
    a.out = (float*)d_out; a.ws = (unsigned char*)d_ws;
#if MK_PER_PHASE
    for (int p = 0; p < NPH; ++p) { a.ph_lo = p; a.ph_hi = p + 1; hipLaunchKernelGGL(layer_fwd, dim3(grid), dim3(NWAVES * 64), LDS_BYTES, stream, a); }
#else
    a.ph_lo = 0; a.ph_hi = NPH; hipLaunchKernelGGL(layer_fwd, dim3(grid), dim3(NWAVES * 64), LDS_BYTES, stream, a);
#endif
    const hipError_t le = hipPeekAtLastError();
    if (le != hipSuccess) fprintf(stderr, "kernel_launch: launch failed: %s\n", hipGetErrorName(le));
}
```

```cpp
#include <hip/hip_runtime.h>
#include <cstdio>
#include <cstdint>

#ifndef MK_PER_PHASE
#define MK_PER_PHASE 0
#endif

#define LAS __attribute__((address_space(3)))
#define GAS __attribute__((address_space(1)))
typedef unsigned short bf16;
typedef short bf16x8 __attribute__((ext_vector_type(8)));
typedef short s16x4 __attribute__((ext_vector_type(4)));
typedef float f32x2 __attribute__((ext_vector_type(2)));
typedef float f32x4 __attribute__((ext_vector_type(4)));
typedef float f32x16 __attribute__((ext_vector_type(16)));
typedef unsigned u32x2 __attribute__((ext_vector_type(2)));
typedef unsigned u32x4 __attribute__((ext_vector_type(4)));

constexpr int BATCH = 8, SEQ = 4096, DM = 1024, M = BATCH * SEQ;
constexpr int NPROJ = 2304;
constexpr int PC_Z = 0, PC_XBC = 512, PC_QL = 1536, PC_KVL = 1920, PC_KR = 2176, PC_DT = 2208;
constexpr int NQ = 768, NKV = 1024, FF = 4096, MEMT = 256;
constexpr int NCHUNK = 32, CHUNK = 128;
constexpr float LN_EPS = 1e-5f, RMS_EPS = 1e-6f;
constexpr float ALPHA = 1.189207115002721f;
constexpr float LOG2E = 1.4426950408889634f;
constexpr float QSCALE = 0.10206207261596577f * LOG2E;
constexpr float MSCALE = 0.0625f * LOG2E;

__device__ __forceinline__ float bf2f(unsigned short x) { return __uint_as_float((unsigned)x << 16); }
__device__ __forceinline__ unsigned cvt_pk_bf16(float lo, float hi) { unsigned r; asm volatile("v_cvt_pk_bf16_f32 %0, %1, %2" : "=v"(r) : "v"(lo), "v"(hi)); return r; }
__device__ __forceinline__ float fast_exp2(float x) { return __builtin_amdgcn_exp2f(x); }
__device__ __forceinline__ float fast_exp(float x) { return __builtin_amdgcn_exp2f(x * LOG2E); }
__device__ __forceinline__ float silu_f(float v) { return v * __builtin_amdgcn_rcpf(1.f + fast_exp(-v)); }

namespace pg8 {
constexpr int BM = 256, BK = 64, HALF = 128, HTB = HALF * BK * 2, STAGE_BYTES = 8 * HTB, NXCD = 8, WGM = 8;
__host__ __device__ __forceinline__ int lds_byte(int r, int c) { const int st = (r >> 4) * 2 + (c >> 5), rr = r & 15, cc = c & 31, ob = rr * 64 + cc * 2; return st * 1024 + (ob ^ (((ob >> 9) & 1) << 5)); }
__host__ __device__ __forceinline__ void stage_rc(int b, int& R, int& C) { const int st = b / 1024, sb = b % 1024, swz = sb ^ (((sb >> 9) & 1) << 5); R = (st >> 1) * 16 + swz / 64; C = (st & 1) * 32 + (swz % 64) / 2; }
__host__ __device__ __forceinline__ int perm32(int rho) { const int n = rho >> 4, i = rho & 15; return 8 * (i >> 2) + 4 * n + (i & 3); }

struct Unit { int pm, pn; };
struct Gemm { const bf16* A; const bf16* Bt; int M, N, K, lda, ldb; };

struct StaticOrder {
    int nM, nN, nwg, G, c;
    __host__ __device__ void init(int M_, int N_, int G_, int c_) { nM = M_ / BM; nN = N_ / BM; nwg = nM * nN; G = G_; c = c_; }
    __host__ __device__ bool next(int i, Unit& u) const {
        const long L = (long)i * G + c; if (L >= nwg) return false;
        int wgid = (int)L; { const int q = nwg / NXCD, r = nwg % NXCD, xcd = wgid % NXCD, off = wgid / NXCD; wgid = (xcd < r ? xcd * (q + 1) : r * (q + 1) + (xcd - r) * q) + off; }
        const int nig = WGM * nN, gid = wgid / nig, fm = gid * WGM, gsz = (nM - fm) < WGM ? (nM - fm) : WGM;
        u.pm = fm + ((wgid % nig) % gsz); u.pn = (wgid % nig) / gsz; return true;
    }
    __device__ __forceinline__ void a_ready(const Unit&) const {}
    __device__ __forceinline__ void done(const Unit&) const {}
};

enum { EK_PROJ = 0, EK_QUP = 1, EK_KVUP = 2, EK_PLAIN = 3, EK_SQRELU = 4 };
struct EpiP {
    static constexpr bool PERM = true, AFTER_DRAIN = false;
    int kind; bf16* O; int ldc;
    float* ssq; float* dt; const float* dt_bias;
    const float* ssq_in; const float* cosT; const float* sinT;
    int split_cols; long split_stride;
    __device__ __forceinline__ void operator()(const f32x4 (&acc)[2][2][4][2], const Unit& u, int wr, int wc, int fr, int fq) const {
        const int row0 = u.pm * BM + wr * 64 + fr;
#pragma unroll
        for (int ai = 0; ai < 2; ++ai)
#pragma unroll
            for (int m = 0; m < 4; ++m) {
                const int row = row0 + ai * HALF + m * 16;
                float rs = 1.f;
                if (kind == EK_QUP) { const f32x4* s = (const f32x4*)(ssq_in + (size_t)row * 24); const f32x4 a = s[0], b = s[1], c = s[2];
                    const float t = ((a[0] + a[1]) + (a[2] + a[3])) + ((b[0] + b[1]) + (b[2] + b[3])) + ((c[0] + c[1]) + (c[2] + c[3]));
                    rs = __builtin_amdgcn_rsqf(t * (1.f / 384.f) + RMS_EPS); }
                else if (kind == EK_KVUP) { const f32x4* s = (const f32x4*)(ssq_in + (size_t)row * 24); const f32x4 a = s[3], b = s[4];
                    const float t = ((a[0] + a[1]) + (a[2] + a[3])) + ((b[0] + b[1]) + (b[2] + b[3]));
                    rs = __builtin_amdgcn_rsqf(t * (1.f / 256.f) + RMS_EPS); }
#pragma unroll
                for (int bj = 0; bj < 2; ++bj) {
                    const int cb = u.pn * BM + bj * HALF + wc * 32 + 8 * fq;
                    float v[8];
#pragma unroll
                    for (int e = 0; e < 4; ++e) { v[e] = acc[ai][bj][m][0][e]; v[4 + e] = acc[ai][bj][m][1][e]; }
                    bf16* dst = O + (size_t)row * ldc + cb;
                    if (kind == EK_PROJ) {
                        if (u.pn >= 6) {
                            float s = 0.f;
#pragma unroll
                            for (int e = 0; e < 8; ++e) s += v[e] * v[e];
                            s += __shfl_xor(s, 16); s += __shfl_xor(s, 32);
                            const int grp = (u.pn * BM + bj * HALF + wc * 32 - PC_QL) >> 5;
                            if (fq == 0 && grp >= 0 && grp < 20) ssq[(size_t)row * 24 + grp] = s;
                            if (cb == PC_DT) {
                                f32x4 d0, d1;
#pragma unroll
                                for (int e = 0; e < 8; ++e) { const float x = v[e] + dt_bias[e]; const float sp = fmaxf(x, 0.f) + log1pf(__expf(-fabsf(x))); if (e < 4) d0[e] = sp; else d1[e - 4] = sp; }
                                *(f32x4*)(dt + (size_t)row * 8) = d0; *(f32x4*)(dt + (size_t)row * 8 + 4) = d1;
                            }
                        }
                    } else if (kind == EK_QUP) {
#pragma unroll
                        for (int e = 0; e < 8; ++e) v[e] *= rs;
                        const int d = cb % 96;
                        if (d >= 64) { const int o8 = (d - 64) >> 3;
                            const f32x4 cs = *(const f32x4*)(cosT + (size_t)row * 16 + 4 * o8), sn = *(const f32x4*)(sinT + (size_t)row * 16 + 4 * o8);
#pragma unroll
                            for (int j = 0; j < 4; ++j) { const float x1 = v[2 * j], x2 = v[2 * j + 1]; v[2 * j] = x1 * cs[j] - x2 * sn[j]; v[2 * j + 1] = x2 * cs[j] + x1 * sn[j]; } }
                    } else if (kind == EK_KVUP) {
#pragma unroll
                        for (int e = 0; e < 8; ++e) v[e] *= rs;
                    } else if (kind == EK_SQRELU) {
#pragma unroll
                        for (int e = 0; e < 8; ++e) { const float t = fmaxf(v[e], 0.f); v[e] = t * t; }
                    } else {
                        if (split_cols) { const int t = cb / split_cols; dst = O + (size_t)t * split_stride + (size_t)row * ldc + (cb - t * split_cols); }
                    }
                    u32x4 w; w.x = cvt_pk_bf16(v[0], v[1]); w.y = cvt_pk_bf16(v[2], v[3]); w.z = cvt_pk_bf16(v[4], v[5]); w.w = cvt_pk_bf16(v[6], v[7]);
                    *(u32x4*)dst = w;
                }
            }
    }
};
struct EpiR {
    static constexpr bool PERM = false, AFTER_DRAIN = false;
    const float* Uold; const float* stats; const float* g; const float* b; float* Unew;
    __device__ __forceinline__ void operator()(const f32x4 (&acc)[2][2][4][2], const Unit& u, int wr, int wc, int fr, int fq) const {
        const int row0 = u.pm * BM + wr * 64 + fr, col0 = u.pn * BM + wc * 32 + 4 * fq;
        f32x4 gv[2][2], bv[2][2];
#pragma unroll
        for (int bj = 0; bj < 2; ++bj)
#pragma unroll
            for (int n = 0; n < 2; ++n) { gv[bj][n] = *(const f32x4*)(g + col0 + bj * HALF + n * 16); bv[bj][n] = *(const f32x4*)(b + col0 + bj * HALF + n * 16); }
#pragma unroll
        for (int ai = 0; ai < 2; ++ai)
#pragma unroll
            for (int m = 0; m < 4; ++m) {
                const int row = row0 + ai * HALF + m * 16;
                const f32x2 st = *(const f32x2*)(stats + (size_t)row * 2);
                const size_t off = (size_t)row * DM + col0;
#pragma unroll
                for (int bj = 0; bj < 2; ++bj)
#pragma unroll
                    for (int n = 0; n < 2; ++n) {
                        const f32x4 uo = *(const f32x4*)(Uold + off + bj * HALF + n * 16);
                        const f32x4 h = (uo - st.x) * st.y * gv[bj][n] + bv[bj][n];
                        *(f32x4*)(Unew + off + bj * HALF + n * 16) = h * ALPHA + acc[ai][bj][m][n];
                    }
            }
    }
};

template <class Epi, class Sched, bool ALIGN_EPI = false, bool SP2 = false>
__device__ __forceinline__ void gemm_phase(LAS unsigned char* lds, const Gemm g, const Sched& S, const Epi& E) {
    const int tid = threadIdx.x, wid = __builtin_amdgcn_readfirstlane(tid >> 6), lane = tid & 63, wr = wid >> 2, wc = wid & 3, fr = lane & 15, fq = lane >> 4;
    const int K = g.K, nt = K / BK;
    unsigned voffA[2], voffB[2];
#pragma unroll
    for (int i = 0; i < 2; ++i) { int R, C; stage_rc(tid * 16 + i * 8192, R, C); const int Rb = Epi::PERM ? ((R & ~31) + perm32(R & 31)) : R;
        voffA[i] = (unsigned)(R * g.lda + C) * 2u; voffB[i] = (unsigned)(Rb * g.ldb + C) * 2u; }
    const size_t kstep = (size_t)(BK * 2);
    const size_t hstepA = (size_t)HALF * g.lda * 2, hstepB = (size_t)HALF * g.ldb * 2;
    const size_t tstepA = 2 * hstepA, tstepB = 2 * hstepB;
    const unsigned ldsw = (unsigned)wid * 1024u;
    const int aoff = lds_byte(wr * 64 + fr, fq * 8), boff = lds_byte(wc * 32 + fr, fq * 8);
#define PG8_SA(b, h) (((b) * 2 + (h)) * HTB)
#define PG8_SB(b, h) ((4 + (b) * 2 + (h)) * HTB)
#define PG8_STAGE(bufoff, gbase, voff) do { _Pragma("unroll") for (int _i = 0; _i < 2; ++_i) \
        __builtin_amdgcn_global_load_lds((const unsigned*)((const char*)(gbase) + (voff)[_i]), (LAS unsigned*)(lds + (bufoff) + ldsw + _i * 8192), 16, 0, 0); } while (0)
#define PG8_LDA(dst, b, h) do { _Pragma("unroll") for (int m = 0; m < 4; ++m) _Pragma("unroll") for (int k = 0; k < 2; ++k) dst[m][k] = *(const LAS bf16x8*)(lds + PG8_SA(b, h) + aoff + m * 2048 + k * 1024); } while (0)
#define PG8_LDB(dst, b, h) do { _Pragma("unroll") for (int n = 0; n < 2; ++n) _Pragma("unroll") for (int k = 0; k < 2; ++k) dst[n][k] = *(const LAS bf16x8*)(lds + PG8_SB(b, h) + boff + n * 2048 + k * 1024); } while (0)
#define PG8_MMA(ai, bj, At, Bt) do { __builtin_amdgcn_s_setprio(1); _Pragma("unroll") for (int m = 0; m < 4; ++m) _Pragma("unroll") for (int n = 0; n < 2; ++n) _Pragma("unroll") for (int k = 0; k < 2; ++k) \
        acc[ai][bj][m][n] = __builtin_amdgcn_mfma_f32_16x16x32_bf16(Bt[n][k], At[m][k], acc[ai][bj][m][n], 0, 0, 0); __builtin_amdgcn_s_setprio(0); } while (0)
#define PG8_WAIT_V(n) asm volatile("s_waitcnt vmcnt(" #n ")" ::: "memory")
#define PG8_WAIT_L(n) asm volatile("s_waitcnt lgkmcnt(" #n ")" ::: "memory")
#define PG8_BAR __builtin_amdgcn_s_barrier()
#define PG8_SCHED __builtin_amdgcn_sched_barrier(0)
    Unit cur, nxt; int ui = 0;
    if (!S.next(0, cur)) return;
    f32x4 acc[2][2][4][2];
#pragma unroll
    for (int a = 0; a < 2; ++a)
#pragma unroll
        for (int b = 0; b < 2; ++b)
#pragma unroll
            for (int m = 0; m < 4; ++m)
#pragma unroll
                for (int n = 0; n < 2; ++n) acc[a][b][m][n] = (f32x4){0.f, 0.f, 0.f, 0.f};
    bf16x8 At[4][2], B0[2][2], B1[2][2];
    const char* cA = (const char*)g.A + (size_t)cur.pm * tstepA; const char* cB = (const char*)g.Bt + (size_t)cur.pn * tstepB;
    S.a_ready(cur);
    if constexpr (SP2) {
        PG8_STAGE(PG8_SB(0, 0), cB, voffB); PG8_STAGE(PG8_SB(0, 1), cB + hstepB, voffB); PG8_STAGE(PG8_SA(0, 0), cA, voffA); PG8_STAGE(PG8_SA(0, 1), cA + hstepA, voffA);
        if (wr == 1) PG8_BAR;
        PG8_WAIT_V(2); PG8_BAR;
        PG8_STAGE(PG8_SB(1, 0), cB + kstep, voffB); PG8_STAGE(PG8_SA(1, 0), cA + kstep, voffA); PG8_STAGE(PG8_SB(1, 1), cB + hstepB + kstep, voffB);
        PG8_WAIT_V(6); PG8_BAR;
    } else {
        PG8_STAGE(PG8_SB(0, 0), cB, voffB); PG8_STAGE(PG8_SA(0, 0), cA, voffA); PG8_STAGE(PG8_SB(0, 1), cB + hstepB, voffB); PG8_STAGE(PG8_SA(0, 1), cA + hstepA, voffA);
        if (wr == 1) PG8_BAR;
        PG8_WAIT_V(4); PG8_BAR;
        PG8_STAGE(PG8_SB(1, 0), cB + kstep, voffB); PG8_STAGE(PG8_SA(1, 0), cA + kstep, voffA); PG8_STAGE(PG8_SB(1, 1), cB + hstepB + kstep, voffB);
        PG8_WAIT_V(6); PG8_BAR;
    }
    for (;;) {
        const bool has_next = S.next(ui + 1, nxt);
        const char* nA = has_next ? (const char*)g.A + (size_t)nxt.pm * tstepA : cA; const char* nB = has_next ? (const char*)g.Bt + (size_t)nxt.pn * tstepB : cB;
        for (int t = 0; t < nt; t += 2) {
            const bool last = (t == nt - 2);
            const char* a1 = cA + (size_t)(t + 1) * kstep;
            const char* a2 = last ? nA : cA + (size_t)(t + 2) * kstep; const char* b2 = last ? nB : cB + (size_t)(t + 2) * kstep;
            const char* a3 = a2 + kstep; const char* b3 = b2 + kstep;
            if (last && has_next) S.a_ready(nxt);
            if constexpr (SP2) {
            PG8_LDB(B0, 0, 0); PG8_LDB(B1, 0, 1); PG8_SCHED; PG8_LDA(At, 0, 0); PG8_STAGE(PG8_SA(1, 1), a1 + hstepA, voffA);
            PG8_WAIT_V(8); PG8_WAIT_L(0); PG8_BAR; PG8_MMA(0, 0, At, B0); PG8_MMA(0, 1, At, B1); PG8_BAR; PG8_SCHED;
            PG8_LDA(At, 0, 1); PG8_STAGE(PG8_SB(0, 0), b2, voffB); PG8_STAGE(PG8_SB(0, 1), b2 + hstepB, voffB); PG8_STAGE(PG8_SA(0, 0), a2, voffA);
            PG8_WAIT_V(8); PG8_WAIT_L(0); PG8_BAR; PG8_MMA(1, 0, At, B0); PG8_MMA(1, 1, At, B1); PG8_BAR; PG8_SCHED;
            PG8_LDB(B0, 1, 0); PG8_LDB(B1, 1, 1); PG8_SCHED; PG8_LDA(At, 1, 0); PG8_STAGE(PG8_SA(0, 1), a2 + hstepA, voffA);
            PG8_WAIT_V(8); PG8_WAIT_L(0); PG8_BAR; PG8_MMA(0, 0, At, B0); PG8_MMA(0, 1, At, B1); PG8_BAR; PG8_SCHED;
            PG8_LDA(At, 1, 1); PG8_STAGE(PG8_SB(1, 0), b3, voffB); PG8_STAGE(PG8_SB(1, 1), b3 + hstepB, voffB); PG8_STAGE(PG8_SA(1, 0), a3, voffA);
            PG8_WAIT_V(8); PG8_WAIT_L(0); PG8_BAR; PG8_MMA(1, 0, At, B0); PG8_MMA(1, 1, At, B1); PG8_BAR; PG8_SCHED;
            } else {
            PG8_LDB(B0, 0, 0); PG8_SCHED; PG8_LDA(At, 0, 0); PG8_STAGE(PG8_SA(1, 1), a1 + hstepA, voffA);
            PG8_WAIT_L(8); PG8_BAR; PG8_WAIT_L(0); PG8_MMA(0, 0, At, B0); PG8_BAR; PG8_SCHED;
            PG8_LDB(B1, 0, 1); PG8_STAGE(PG8_SB(0, 0), b2, voffB);
            PG8_BAR; PG8_WAIT_L(0); PG8_MMA(0, 1, At, B1); PG8_BAR;
            PG8_LDA(At, 0, 1); PG8_STAGE(PG8_SA(0, 0), a2, voffA);
            PG8_BAR; PG8_WAIT_L(0); PG8_MMA(1, 0, At, B0); PG8_BAR; PG8_SCHED;
            PG8_STAGE(PG8_SB(0, 1), b2 + hstepB, voffB);
            PG8_WAIT_V(6); PG8_BAR; PG8_MMA(1, 1, At, B1); PG8_BAR;
            PG8_LDB(B0, 1, 0); PG8_SCHED; PG8_LDA(At, 1, 0); PG8_STAGE(PG8_SA(0, 1), a2 + hstepA, voffA);
            PG8_WAIT_L(8); PG8_BAR; PG8_WAIT_L(0); PG8_MMA(0, 0, At, B0); PG8_BAR; PG8_SCHED;
            PG8_LDB(B1, 1, 1); PG8_STAGE(PG8_SB(1, 0), b3, voffB);
            PG8_BAR; PG8_WAIT_L(0); PG8_MMA(0, 1, At, B1); PG8_BAR;
            PG8_LDA(At, 1, 1); PG8_STAGE(PG8_SA(1, 0), a3, voffA);
            PG8_BAR; PG8_WAIT_L(0); PG8_MMA(1, 0, At, B0); PG8_BAR; PG8_SCHED;
            PG8_STAGE(PG8_SB(1, 1), b3 + hstepB, voffB);
            PG8_WAIT_V(6); PG8_BAR; PG8_MMA(1, 1, At, B1); PG8_BAR;
            }
        }
        if constexpr (ALIGN_EPI) { if (wr == 0) PG8_BAR; }
        if constexpr (!Epi::AFTER_DRAIN) { E(acc, cur, wr, wc, fr, fq); S.done(cur); }
        if (!has_next) break;
#pragma unroll
        for (int a = 0; a < 2; ++a)
#pragma unroll
            for (int b = 0; b < 2; ++b)
#pragma unroll
                for (int m = 0; m < 4; ++m)
#pragma unroll
                    for (int n = 0; n < 2; ++n) acc[a][b][m][n] = (f32x4){0.f, 0.f, 0.f, 0.f};
        cur = nxt; cA = nA; cB = nB; ++ui;
        if constexpr (ALIGN_EPI) { if (wr == 1) PG8_BAR; }
    }
    PG8_WAIT_V(0);
    if constexpr (!ALIGN_EPI) { if (wr == 0) PG8_BAR; }
    PG8_BAR;
#undef PG8_SA
#undef PG8_SB
#undef PG8_STAGE
#undef PG8_LDA
#undef PG8_LDB
#undef PG8_MMA
#undef PG8_WAIT_V
#undef PG8_WAIT_L
#undef PG8_BAR
#undef PG8_SCHED
}
}

namespace att {
__device__ __forceinline__ int crow(int r, int hi) { return (r & 3) + 8 * (r >> 2) + 4 * hi; }
typedef short v4i16_t __attribute__((ext_vector_type(4)));
__device__ __forceinline__ s16x4 vtr(const char* p) { return __builtin_bit_cast(s16x4, __builtin_amdgcn_ds_read_tr16_b64_v4i16((LAS v4i16_t*)(unsigned)(uintptr_t)p)); }
__device__ __forceinline__ float xh_max(float v) { auto rr = __builtin_amdgcn_permlane32_swap(__float_as_uint(v), __float_as_uint(v), false, false); return fmaxf(__uint_as_float(rr[0]), __uint_as_float(rr[1])); }
__device__ __forceinline__ float xh_sum(float v) { auto rr = __builtin_amdgcn_permlane32_swap(__float_as_uint(v), __float_as_uint(v), false, false); return __uint_as_float(rr[0]) + __uint_as_float(rr[1]); }

__device__ __forceinline__ void softmax_tile(f32x16& p0, f32x16& p1, float& m, float& l, float& alpha) {
    float pm = fmaxf(p0[0], p1[0]);
#pragma unroll
    for (int r = 1; r < 16; ++r) pm = fmaxf(pm, fmaxf(p0[r], p1[r]));
    pm = xh_max(pm);
    const float mn = fmaxf(m, pm); alpha = fast_exp2(m - mn); m = mn;
    float ps = 0.f;
#pragma unroll
    for (int r = 0; r < 16; ++r) { p0[r] = fast_exp2(p0[r] - mn); p1[r] = fast_exp2(p1[r] - mn); ps += p0[r] + p1[r]; }
    ps = xh_sum(ps);
    l = l * alpha + ps;
}
#define ATT_PKW(P, B) cvt_pk_bf16(P[B], P[B + 1])
#define ATT_PACK(P0, P1) \
    const u32x4 pw0 = {ATT_PKW(P0, 0), ATT_PKW(P0, 2), ATT_PKW(P0, 4), ATT_PKW(P0, 6)}, pw1 = {ATT_PKW(P0, 8), ATT_PKW(P0, 10), ATT_PKW(P0, 12), ATT_PKW(P0, 14)}, \
                pw2 = {ATT_PKW(P1, 0), ATT_PKW(P1, 2), ATT_PKW(P1, 4), ATT_PKW(P1, 6)}, pw3 = {ATT_PKW(P1, 8), ATT_PKW(P1, 10), ATT_PKW(P1, 12), ATT_PKW(P1, 14)}
#define ATT_VFR(L, H) (bf16x8){L[0], L[1], L[2], L[3], H[0], H[1], H[2], H[3]}

constexpr int S_K = 0, S_V = 12288, S_WS = 20480, S_OST = S_WS + 8 * 256, S_BYTES = S_OST + 8 * 4096;
__device__ __forceinline__ void self_unit(int b, int h, int qb, const bf16* Q, const bf16* KV, const bf16* KPE, bf16* YO, char* shm) {
    const int tid = threadIdx.x, lane = tid & 63, r32 = lane & 31, hi = lane >> 5; const int wid = __builtin_amdgcn_readfirstlane(tid >> 6);
    const long rowbase = (long)b * SEQ; const int q0 = qb * 256;
    const bf16* Qw = Q + (rowbase + q0 + wid * 32 + r32) * NQ + h * 96 + hi * 8;
    bf16x8 qr[6];
#pragma unroll
    for (int d0 = 0; d0 < 6; ++d0) qr[d0] = *(const bf16x8*)(Qw + d0 * 16);
    float* wsf = (float*)(shm + S_WS) + wid * 64;
    const int NT = (q0 + 256) / 64;
    const int srow = tid & 63, sch = tid >> 6;
    const bf16* kn_src = KV + (rowbase + srow) * NKV + h * 64 + sch * 8;
    const bf16* kp_src = KPE + (rowbase + srow) * 32 + (sch & 3) * 8;
    const bf16* v_src = KV + (rowbase + srow) * NKV + 512 + h * 64 + sch * 8;
    char* kn_dst = shm + S_K + sch * 1024 + srow * 16;
    char* kp_dst = shm + S_K + (8 + (sch & 3)) * 1024 + srow * 16;
    char* v_dst = shm + S_V + (sch >> 2) * 4096 + srow * 64 + (sch & 3) * 16;
    const char* kb = shm + S_K + hi * 1024 + r32 * 16;
    const char* vb = shm + S_V + ((lane >> 4) & 1) * 32 + (lane & 3) * 8 + (4 * hi + ((lane & 15) >> 2)) * 64;
    float m_reg = -1e30f, l_reg = 0.f; f32x16 o[2]; o[0] = f32x16{}; o[1] = f32x16{};
    const int qrel = wid * 32 + r32;
    bf16x8 sk0, sk1 = bf16x8{}, sv;
    sk0 = *(const bf16x8*)kn_src; if (tid < 256) sk1 = *(const bf16x8*)kp_src; sv = *(const bf16x8*)v_src;
    for (int t = 0; t < NT; ++t) {
        __syncthreads();
        *(bf16x8*)kn_dst = sk0; if (tid < 256) *(bf16x8*)kp_dst = sk1; *(bf16x8*)v_dst = sv;
        __syncthreads();
        if (t + 1 < NT) { const long ko = (long)(t + 1) * 64;
            sk0 = *(const bf16x8*)(kn_src + ko * NKV); if (tid < 256) sk1 = *(const bf16x8*)(kp_src + ko * 32); sv = *(const bf16x8*)(v_src + ko * NKV); }
        f32x16 p0 = f32x16{}, p1 = f32x16{};
#pragma unroll
        for (int d0 = 0; d0 < 6; ++d0) {
            const bf16x8 k0 = *(const bf16x8*)(kb + d0 * 2048), k1 = *(const bf16x8*)(kb + d0 * 2048 + 512);
            p0 = __builtin_amdgcn_mfma_f32_32x32x16_bf16(k0, qr[d0], p0, 0, 0, 0);
            p1 = __builtin_amdgcn_mfma_f32_32x32x16_bf16(k1, qr[d0], p1, 0, 0, 0);
        }
        const int jb = t - (NT - 4);
        if (jb >= 0) { const int kbase = 64 * jb + 4 * hi;
#pragma unroll
            for (int r = 0; r < 16; ++r) { const int kv = kbase + (r & 3) + 8 * (r >> 2); if (kv > qrel) p0[r] = -INFINITY; if (kv + 32 > qrel) p1[r] = -INFINITY; } }
        float alpha;
        softmax_tile(p0, p1, m_reg, l_reg, alpha);
        if (__any(alpha < 1.f)) {
            if (hi == 0) wsf[r32] = alpha;
            asm volatile("s_waitcnt lgkmcnt(0)" ::: "memory");
#pragma unroll
            for (int r = 0; r < 16; ++r) { const float a = wsf[crow(r, hi)]; o[0][r] *= a; o[1][r] *= a; }
        }
        ATT_PACK(p0, p1);
#pragma unroll
        for (int db = 0; db < 2; ++db) {
            const s16x4 l0 = vtr(vb + db * 4096), h0 = vtr(vb + db * 4096 + 512), l1 = vtr(vb + db * 4096 + 1024), h1 = vtr(vb + db * 4096 + 1536);
            const s16x4 l2 = vtr(vb + db * 4096 + 2048), h2 = vtr(vb + db * 4096 + 2560), l3 = vtr(vb + db * 4096 + 3072), h3 = vtr(vb + db * 4096 + 3584);
            o[db] = __builtin_amdgcn_mfma_f32_32x32x16_bf16(__builtin_bit_cast(bf16x8, pw0), ATT_VFR(l0, h0), o[db], 0, 0, 0);
            o[db] = __builtin_amdgcn_mfma_f32_32x32x16_bf16(__builtin_bit_cast(bf16x8, pw1), ATT_VFR(l1, h1), o[db], 0, 0, 0);
            o[db] = __builtin_amdgcn_mfma_f32_32x32x16_bf16(__builtin_bit_cast(bf16x8, pw2), ATT_VFR(l2, h2), o[db], 0, 0, 0);
            o[db] = __builtin_amdgcn_mfma_f32_32x32x16_bf16(__builtin_bit_cast(bf16x8, pw3), ATT_VFR(l3, h3), o[db], 0, 0, 0);
        }
    }
    if (hi == 0) wsf[32 + r32] = l_reg;
    asm volatile("s_waitcnt lgkmcnt(0)" ::: "memory");
    bf16* stg = (bf16*)(shm + S_OST) + wid * 2048;
#pragma unroll
    for (int r = 0; r < 16; ++r) { const int orow = crow(r, hi); const float rl = __builtin_amdgcn_rcpf(wsf[32 + orow]);
#pragma unroll
        for (int db = 0; db < 2; ++db) stg[orow * 64 + db * 32 + r32] = (bf16)(cvt_pk_bf16(o[db][r] * rl, 0.f) & 0xffffu); }
    asm volatile("s_waitcnt lgkmcnt(0)" ::: "memory");
    bf16* Ow = YO + (rowbase + q0 + wid * 32) * DM + 512 + h * 64;
#pragma unroll
    for (int i = 0; i < 4; ++i) { const int row = i * 8 + (lane >> 3), ch = lane & 7; const u32x4 v = *(const u32x4*)(stg + row * 64 + ch * 8); *(u32x4*)(Ow + (long)row * DM + ch * 8) = v; }
}

constexpr int X_K = 0, X_V = 32768, X_WS = 65536, X_OST = X_WS + 8 * 256, X_BYTES = X_OST + 8 * 8192;
__device__ __forceinline__ void cross_unit(int b, int h, int qt, const bf16* QM, const bf16* KM, const bf16* VM, bf16* OM, char* shm) {
    const int tid = threadIdx.x, lane = tid & 63, r32 = lane & 31, hi = lane >> 5; const int wid = __builtin_amdgcn_readfirstlane(tid >> 6);
    const int qg = wid >> 1, dh = wid & 1;
    const long qrow0 = (long)b * SEQ + qt * 128 + qg * 32;
    const bf16* Qw = QM + (qrow0 + r32) * DM + h * 256 + hi * 8;
    float* wsf = (float*)(shm + X_WS) + wid * 64;
    const int srow = tid & 63, sch = tid >> 6;
    const bf16* k_src = KM + ((long)b * MEMT + srow) * DM + h * 256 + sch * 8;
    const bf16* v_src = VM + ((long)b * MEMT + srow) * DM + h * 256 + sch * 8;
    const char* kb = shm + X_K + hi * 1024 + r32 * 16;
    const char* vb = shm + X_V + dh * 16384 + ((lane >> 4) & 1) * 32 + (lane & 3) * 8 + (4 * hi + ((lane & 15) >> 2)) * 64;
    float m_reg = -1e30f, l_reg = 0.f; f32x16 o[4];
#pragma unroll
    for (int d = 0; d < 4; ++d) o[d] = f32x16{};
    bf16x8 sg[4];
#pragma unroll
    for (int it = 0; it < 4; ++it) sg[it] = *(const bf16x8*)(k_src + it * 64);
    for (int t = 0; t < 4; ++t) {
        __syncthreads();
#pragma unroll
        for (int it = 0; it < 4; ++it) { const int ch = it * 8 + sch; *(bf16x8*)(shm + X_K + ch * 1024 + srow * 16) = sg[it]; }
        __syncthreads();
#pragma unroll
        for (int it = 0; it < 4; ++it) sg[it] = *(const bf16x8*)(v_src + (long)t * 64 * DM + it * 64);
        f32x16 p0 = f32x16{}, p1 = f32x16{};
        const bf16* Qt = Qw; asm volatile("" : "+v"(Qt));
#pragma unroll
        for (int d0 = 0; d0 < 16; ++d0) {
            const bf16x8 qf = *(const bf16x8*)(Qt + d0 * 16);
            const bf16x8 k0 = *(const bf16x8*)(kb + d0 * 2048), k1 = *(const bf16x8*)(kb + d0 * 2048 + 512);
            p0 = __builtin_amdgcn_mfma_f32_32x32x16_bf16(k0, qf, p0, 0, 0, 0);
            p1 = __builtin_amdgcn_mfma_f32_32x32x16_bf16(k1, qf, p1, 0, 0, 0);
        }
#pragma unroll
        for (int it = 0; it < 4; ++it) { const int ch = it * 8 + sch; *(bf16x8*)(shm + X_V + (ch >> 2) * 4096 + srow * 64 + (ch & 3) * 16) = sg[it]; }
        __syncthreads();
        if (t + 1 < 4) {
#pragma unroll
            for (int it = 0; it < 4; ++it) sg[it] = *(const bf16x8*)(k_src + (long)(t + 1) * 64 * DM + it * 64);
        }
        float alpha;
        softmax_tile(p0, p1, m_reg, l_reg, alpha);
        if (__any(alpha < 1.f)) {
            if (hi == 0) wsf[r32] = alpha;
            asm volatile("s_waitcnt lgkmcnt(0)" ::: "memory");
#pragma unroll
            for (int r = 0; r < 16; ++r) { const float a = wsf[crow(r, hi)];
#pragma unroll
                for (int d = 0; d < 4; ++d) o[d][r] *= a; }
        }
        ATT_PACK(p0, p1);
#pragma unroll
        for (int db = 0; db < 4; ++db) {
            const s16x4 l0 = vtr(vb + db * 4096), h0 = vtr(vb + db * 4096 + 512), l1 = vtr(vb + db * 4096 + 1024), h1 = vtr(vb + db * 4096 + 1536);
            const s16x4 l2 = vtr(vb + db * 4096 + 2048), h2 = vtr(vb + db * 4096 + 2560), l3 = vtr(vb + db * 4096 + 3072), h3 = vtr(vb + db * 4096 + 3584);
            o[db] = __builtin_amdgcn_mfma_f32_32x32x16_bf16(__builtin_bit_cast(bf16x8, pw0), ATT_VFR(l0, h0), o[db], 0, 0, 0);
            o[db] = __builtin_amdgcn_mfma_f32_32x32x16_bf16(__builtin_bit_cast(bf16x8, pw1), ATT_VFR(l1, h1), o[db], 0, 0, 0);
            o[db] = __builtin_amdgcn_mfma_f32_32x32x16_bf16(__builtin_bit_cast(bf16x8, pw2), ATT_VFR(l2, h2), o[db], 0, 0, 0);
            o[db] = __builtin_amdgcn_mfma_f32_32x32x16_bf16(__builtin_bit_cast(bf16x8, pw3), ATT_VFR(l3, h3), o[db], 0, 0, 0);
        }
    }
    if (hi == 0) wsf[32 + r32] = l_reg;
    asm volatile("s_waitcnt lgkmcnt(0)" ::: "memory");
    bf16* stg = (bf16*)(shm + X_OST) + wid * 4096;
#pragma unroll
    for (int r = 0; r < 16; ++r) { const int orow = crow(r, hi); const float rl = __builtin_amdgcn_rcpf(wsf[32 + orow]);
#pragma unroll
        for (int db = 0; db < 4; ++db) stg[orow * 128 + db * 32 + r32] = (bf16)(cvt_pk_bf16(o[db][r] * rl, 0.f) & 0xffffu); }
    asm volatile("s_waitcnt lgkmcnt(0)" ::: "memory");
    bf16* Ow = OM + qrow0 * DM + h * 256 + dh * 128;
#pragma unroll
    for (int i = 0; i < 8; ++i) { const int row = i * 4 + (lane >> 4), ch = lane & 15; const u32x4 v = *(const u32x4*)(stg + row * 128 + ch * 8); *(u32x4*)(Ow + (long)row * DM + ch * 8) = v; }
    __syncthreads();
}
}

namespace ssd {
constexpr int PB = 288;
constexpr int PXD = 544;
constexpr int PXS = 160;
typedef short v4i16_t __attribute__((ext_vector_type(4)));
__device__ __forceinline__ s16x4 vtr(const char* p) { return __builtin_bit_cast(s16x4, __builtin_amdgcn_ds_read_tr16_b64_v4i16((LAS v4i16_t*)(unsigned)(uintptr_t)p)); }
#define SSD_FR(L, H) (bf16x8){L[0], L[1], L[2], L[3], H[0], H[1], H[2], H[3]}

struct ConvW { float w[4][8]; float b[8]; };
__device__ __forceinline__ void load_convw(ConvW& cw, const float* conv_w, const float* conv_b, int ch) {
#pragma unroll
    for (int k = 0; k < 4; ++k) { const f32x4 a = *(const f32x4*)(conv_w + k * 1024 + ch), c = *(const f32x4*)(conv_w + k * 1024 + ch + 4);
#pragma unroll
        for (int e = 0; e < 4; ++e) { cw.w[k][e] = a[e]; cw.w[k][4 + e] = c[e]; } }
    const f32x4 a = *(const f32x4*)(conv_b + ch), c = *(const f32x4*)(conv_b + ch + 4);
#pragma unroll
    for (int e = 0; e < 4; ++e) { cw.b[e] = a[e]; cw.b[4 + e] = c[e]; }
}
__device__ __forceinline__ void conv8(const bf16* PROJ, long grow, int spos, int ch, const ConvW& cw, float (&out)[8]) {
    float a[8];
#pragma unroll
    for (int e = 0; e < 8; ++e) a[e] = cw.b[e];
#pragma unroll
    for (int k = 0; k < 4; ++k) {
        if (spos - 3 + k >= 0) {
            const bf16x8 x = *(const bf16x8*)(PROJ + (grow - 3 + k) * NPROJ + PC_XBC + ch);
#pragma unroll
            for (int e = 0; e < 8; ++e) a[e] += cw.w[k][e] * bf2f((unsigned short)x[e]);
        }
    }
#pragma unroll
    for (int e = 0; e < 8; ++e) out[e] = silu_f(a[e]);
}
__device__ __forceinline__ u32x4 pack8(const float (&v)[8]) { u32x4 w; w.x = cvt_pk_bf16(v[0], v[1]); w.y = cvt_pk_bf16(v[2], v[3]); w.z = cvt_pk_bf16(v[4], v[5]); w.w = cvt_pk_bf16(v[6], v[7]); return w; }

__device__ __forceinline__ void chunk_acs(const float* DT, const float* a_log, long R0, int g, float* a_s, float* d_s) {
    const int tid = threadIdx.x, hh = tid >> 7, l = tid & 127, h = 4 * g + hh;
    const float dtv = DT[(R0 + l) * 8 + h];
    const float Ah = -__expf(a_log[h]);
    d_s[hh * 128 + l] = dtv * Ah;
    __syncthreads();
    float cs = 0.f;
    for (int i = 0; i <= l; ++i) cs += d_s[hh * 128 + i];
    a_s[hh * 128 + l] = cs;
    __syncthreads();
    d_s[hh * 128 + l] = dtv;
    __syncthreads();
}

constexpr int A_AS = 0, A_DS = 2048, A_BS = 4096, A_XD = A_BS + 128 * PB, A_BYTES = A_XD + 128 * PXD;
__device__ __forceinline__ void pass_a_unit(int unit, const bf16* PROJ, const float* DT, const float* a_log, const float* conv_w, const float* conv_b, float* ST, float* CD, char* shm) {
    const int tid = threadIdx.x, lane = tid & 63; const int wid = __builtin_amdgcn_readfirstlane(tid >> 6);
    const int g = unit & 1, c = (unit >> 1) & 31, b = unit >> 6;
    const long R0 = (long)b * SEQ + c * CHUNK;
    float* a_s = (float*)(shm + A_AS); float* d_s = (float*)(shm + A_DS);
    __syncthreads();
    chunk_acs(DT, a_log, R0, g, a_s, d_s);
    {
        const int hh = tid >> 7, l = tid & 127;
        const float tot = a_s[hh * 128 + 127], cs = a_s[hh * 128 + l], dtv = d_s[hh * 128 + l];
        __syncthreads();
        d_s[hh * 128 + l] = dtv * __expf(tot - cs);
        if (l == 127) CD[((long)b * NCHUNK + c) * 8 + 4 * g + hh] = __expf(tot);
    }
    __syncthreads();
    {
        const int o = tid & 31, ch = 256 * g + 8 * o, hh = o >> 3; ConvW cw; load_convw(cw, conv_w, conv_b, ch);
        for (int it = 0; it < 8; ++it) { const int l = it * 16 + (tid >> 5); float v[8]; conv8(PROJ, R0 + l, c * CHUNK + l, ch, cw, v);
            const float w = d_s[hh * 128 + l];
#pragma unroll
            for (int e = 0; e < 8; ++e) v[e] *= w;
            *(u32x4*)(shm + A_XD + l * PXD + o * 16) = pack8(v); }
    }
    {
        const int o = tid & 15, ch = 512 + 128 * g + 8 * o; ConvW cw; load_convw(cw, conv_w, conv_b, ch);
        for (int it = 0; it < 4; ++it) { const int l = it * 32 + (tid >> 4); float v[8]; conv8(PROJ, R0 + l, c * CHUNK + l, ch, cw, v);
            *(u32x4*)(shm + A_BS + l * PB + o * 16) = pack8(v); }
    }
    __syncthreads();
    const int hh = wid >> 1, nh = wid & 1, i16 = lane & 15, g4 = lane >> 4, q4 = (lane & 15) >> 2, p4 = lane & 3;
    f32x4 acc[4][4];
#pragma unroll
    for (int pt = 0; pt < 4; ++pt)
#pragma unroll
        for (int nt = 0; nt < 4; ++nt) acc[pt][nt] = (f32x4){0.f, 0.f, 0.f, 0.f};
#pragma unroll
    for (int ks = 0; ks < 4; ++ks) {
        const int rk = ks * 32 + 8 * g4 + q4;
        bf16x8 af[4], bfr[4];
#pragma unroll
        for (int pt = 0; pt < 4; ++pt) { const char* p = shm + A_XD + rk * PXD + (hh * 64 + pt * 16 + 4 * p4) * 2; const s16x4 lo = vtr(p), hi = vtr(p + 4 * PXD); af[pt] = SSD_FR(lo, hi); }
#pragma unroll
        for (int nt = 0; nt < 4; ++nt) { const char* p = shm + A_BS + rk * PB + (nh * 64 + nt * 16 + 4 * p4) * 2; const s16x4 lo = vtr(p), hi = vtr(p + 4 * PB); bfr[nt] = SSD_FR(lo, hi); }
#pragma unroll
        for (int pt = 0; pt < 4; ++pt)
#pragma unroll
            for (int nt = 0; nt < 4; ++nt) acc[pt][nt] = __builtin_amdgcn_mfma_f32_16x16x32_bf16(af[pt], bfr[nt], acc[pt][nt], 0, 0, 0);
    }
    float* dst = ST + ((((long)b * NCHUNK + c) * 8 + 4 * g + hh) * 64) * 128 + nh * 64 + i16;
#pragma unroll
    for (int pt = 0; pt < 4; ++pt)
#pragma unroll
        for (int nt = 0; nt < 4; ++nt)
#pragma unroll
            for (int r = 0; r < 4; ++r) dst[(long)(pt * 16 + 4 * g4 + r) * 128 + nt * 16] = acc[pt][nt][r];
}

constexpr int C_AS = 0, C_DS = 2048, C_CS = 4096, C_BS = C_CS + 128 * PB, C_MH = C_BS + 128 * PB, C_XS = C_MH + 128 * PB, C_BYTES = C_XS + 128 * PXS;
__device__ __forceinline__ void pass_c_unit(int unit, const bf16* PROJ, const float* DT, const float* a_log, const float* conv_w, const float* conv_b,
                                            const bf16* PREV, const float* d_skip, const float* norm_g, float* YT, bf16* YO, char* shm) {
    const int tid = threadIdx.x, lane = tid & 63; const int wid = __builtin_amdgcn_readfirstlane(tid >> 6);
    const int g = unit & 1, c = (unit >> 1) & 31, b = unit >> 6;
    const long R0 = (long)b * SEQ + c * CHUNK;
    float* a_s = (float*)(shm + C_AS); float* d_s = (float*)(shm + C_DS);
    const int i16 = lane & 15, g4 = lane >> 4, q4 = (lane & 15) >> 2, p4 = lane & 3;
    __syncthreads();
    chunk_acs(DT, a_log, R0, g, a_s, d_s);
    {
        const int o = tid & 15;
        { const int ch = 512 + 128 * g + 8 * o; ConvW cw; load_convw(cw, conv_w, conv_b, ch);
          for (int it = 0; it < 4; ++it) { const int l = it * 32 + (tid >> 4); float v[8]; conv8(PROJ, R0 + l, c * CHUNK + l, ch, cw, v); *(u32x4*)(shm + C_BS + l * PB + o * 16) = pack8(v); } }
        { const int ch = 768 + 128 * g + 8 * o; ConvW cw; load_convw(cw, conv_w, conv_b, ch);
          for (int it = 0; it < 4; ++it) { const int l = it * 32 + (tid >> 4); float v[8]; conv8(PROJ, R0 + l, c * CHUNK + l, ch, cw, v); *(u32x4*)(shm + C_CS + l * PB + o * 16) = pack8(v); } }
    }
    __syncthreads();
    float ss[4] = {0.f, 0.f, 0.f, 0.f};
#pragma unroll 1
    for (int hh = 0; hh < 4; ++hh) {
        const int h = 4 * g + hh;
        {
            const int o = tid & 7, ch = 256 * g + 64 * hh + 8 * o; ConvW cw; load_convw(cw, conv_w, conv_b, ch);
            for (int it = 0; it < 2; ++it) { const int l = it * 64 + (tid >> 3); float v[8]; conv8(PROJ, R0 + l, c * CHUNK + l, ch, cw, v); *(u32x4*)(shm + C_XS + l * PXS + o * 16) = pack8(v); }
        }
        {
            bf16x8 cfr[4];
#pragma unroll
            for (int ks = 0; ks < 4; ++ks) cfr[ks] = *(const bf16x8*)(shm + C_CS + (16 * wid + i16) * PB + (ks * 32 + 8 * g4) * 2);
            float al[4];
#pragma unroll
            for (int r = 0; r < 4; ++r) al[r] = a_s[hh * 128 + 16 * wid + 4 * g4 + r];
#pragma unroll
            for (int st = 0; st < 8; ++st) {
                f32x4 cb = (f32x4){0.f, 0.f, 0.f, 0.f};
#pragma unroll
                for (int ks = 0; ks < 4; ++ks) { const bf16x8 bfr = *(const bf16x8*)(shm + C_BS + (16 * st + i16) * PB + (ks * 32 + 8 * g4) * 2);
                    cb = __builtin_amdgcn_mfma_f32_16x16x32_bf16(cfr[ks], bfr, cb, 0, 0, 0); }
                const int s = 16 * st + i16; const float as_ = a_s[hh * 128 + s], ds_ = d_s[hh * 128 + s];
#pragma unroll
                for (int r = 0; r < 4; ++r) { const int l = 16 * wid + 4 * g4 + r;
                    const float v = (s <= l) ? cb[r] * __expf(al[r] - as_) * ds_ : 0.f;
                    *(bf16*)(shm + C_MH + l * PB + s * 2) = (bf16)(cvt_pk_bf16(v, 0.f) & 0xffffu); }
            }
        }
        __syncthreads();
        f32x4 yd[4], yo[4];
#pragma unroll
        for (int pt = 0; pt < 4; ++pt) { yd[pt] = (f32x4){0.f, 0.f, 0.f, 0.f}; yo[pt] = (f32x4){0.f, 0.f, 0.f, 0.f}; }
        const bf16* prev_h = PREV + ((((long)b * NCHUNK + c) * 8 + h) * 64) * 128;
#pragma unroll
        for (int ks = 0; ks < 4; ++ks) {
            const bf16x8 mfr = *(const bf16x8*)(shm + C_MH + (16 * wid + i16) * PB + (ks * 32 + 8 * g4) * 2);
            const bf16x8 cf = *(const bf16x8*)(shm + C_CS + (16 * wid + i16) * PB + (ks * 32 + 8 * g4) * 2);
            const int rk = ks * 32 + 8 * g4 + q4;
#pragma unroll
            for (int pt = 0; pt < 4; ++pt) {
                const char* p = shm + C_XS + rk * PXS + (pt * 16 + 4 * p4) * 2; const s16x4 lo = vtr(p), hi = vtr(p + 4 * PXS);
                yd[pt] = __builtin_amdgcn_mfma_f32_16x16x32_bf16(mfr, SSD_FR(lo, hi), yd[pt], 0, 0, 0);
                const bf16x8 pf = *(const bf16x8*)(prev_h + (long)(pt * 16 + i16) * 128 + ks * 32 + 8 * g4);
                yo[pt] = __builtin_amdgcn_mfma_f32_16x16x32_bf16(cf, pf, yo[pt], 0, 0, 0);
            }
        }
        const float Dh = d_skip[h];
#pragma unroll
        for (int r = 0; r < 4; ++r) { const int l = 16 * wid + 4 * g4 + r; const float ea = __expf(a_s[hh * 128 + l]);
#pragma unroll
            for (int pt = 0; pt < 4; ++pt) { const int p = pt * 16 + i16;
                const float xs = bf2f(*(const bf16*)(shm + C_XS + l * PXS + p * 2));
                const float z = bf2f(PROJ[(R0 + l) * NPROJ + PC_Z + 64 * h + p]);
                float y = yd[pt][r] + ea * yo[pt][r] + xs * Dh;
                y *= silu_f(z);
                YT[(R0 + l) * 512 + 64 * h + p] = y; ss[r] += y * y; } }
        __syncthreads();
    }
#pragma unroll
    for (int r = 0; r < 4; ++r) { float s = ss[r]; s += __shfl_xor(s, 1); s += __shfl_xor(s, 2); s += __shfl_xor(s, 4); s += __shfl_xor(s, 8); ss[r] = __builtin_amdgcn_rsqf(s * (1.f / 256.f) + RMS_EPS); }
#pragma unroll 1
    for (int hh = 0; hh < 4; ++hh)
#pragma unroll
        for (int pt = 0; pt < 4; ++pt) { const int ch = 256 * g + 64 * hh + pt * 16 + i16; const float ng = norm_g[ch];
#pragma unroll
            for (int r = 0; r < 4; ++r) { const int l = 16 * wid + 4 * g4 + r;
                const float y = YT[(R0 + l) * 512 + ch];
                YO[(R0 + l) * DM + ch] = (bf16)(cvt_pk_bf16(y * ss[r] * ng, 0.f) & 0xffffu); } }
}
}

constexpr size_t MiB = 1u << 20;
constexpr size_t WS_CTL = 0, CTL_ZERO_BYTES = 1 * MiB;
constexpr size_t WS_STATS = 1 * MiB;
constexpr size_t WS_CD = WS_STATS + 3 * (size_t)M * 2 * 4;
constexpr size_t WS_WIN = 2 * MiB;
constexpr size_t WS_WQ = WS_WIN + (size_t)NPROJ * DM * 2;
constexpr size_t WS_WKV = WS_WQ + (size_t)NQ * 384 * 2;
constexpr size_t WS_WMIX = WS_WKV + (size_t)NKV * 256 * 2;
constexpr size_t WS_WMQ = WS_WMIX + 2 * MiB;
constexpr size_t WS_WMKV = WS_WMQ + 2 * MiB;
constexpr size_t WS_WMO = WS_WMKV + 4 * MiB;
constexpr size_t WS_WUP = WS_WMO + 2 * MiB;
constexpr size_t WS_WDN = WS_WUP + 8 * MiB;
constexpr size_t WS_WEND = WS_WDN + 8 * MiB;
static_assert(WS_WEND <= 34 * MiB, "weights");
constexpr size_t WS_MEMB = 34 * MiB, WS_KM = 38 * MiB, WS_VM = 42 * MiB;
constexpr size_t WS_KPE = 46 * MiB;
constexpr size_t WS_COS = 48 * MiB, WS_SIN = 50 * MiB;
constexpr size_t WS_DT = 52 * MiB;
constexpr size_t WS_SSQ = 53 * MiB;
constexpr size_t WS_XN = 56 * MiB;
constexpr size_t WS_YO = WS_XN;
constexpr size_t WS_U2 = 120 * MiB;
constexpr size_t WS_Q = 120 * MiB, WS_KV = 168 * MiB;
constexpr size_t WS_HB = 248 * MiB;
constexpr size_t WS_PROJ = 248 * MiB;
constexpr size_t WS_ST = 392 * MiB;
constexpr size_t WS_PREV = 456 * MiB;
constexpr size_t WS_QM = 248 * MiB, WS_OM = 312 * MiB;
constexpr size_t WS_END = 504 * MiB;
static_assert(WS_KV + (size_t)M * NKV * 2 <= WS_HB && WS_PREV + 32 * MiB <= WS_END && WS_SSQ + (size_t)M * 24 * 4 <= WS_XN, "d_ws map");

typedef GAS unsigned gu32;
#define RLX_AGENT __ATOMIC_RELAXED, __HIP_MEMORY_SCOPE_AGENT
#define XB_TMO      128
#define XB_XCNT(j)  (256  + 64 * (j))
#define XB_XSUB(j)  (1280 + 64 * (j))
#define XB_XGEN(j)  (2304 + 64 * (j))
#define XB_TOP      3328
#define XB_TOPGEN   3392
#define XCD_BAR_WORDS 3456
#define XB_SPIN_CAP (1u << 18)
__device__ __forceinline__ unsigned xb_ld(unsigned* p)              { return __hip_atomic_load(p, __ATOMIC_RELAXED, __HIP_MEMORY_SCOPE_AGENT); }
__device__ __forceinline__ unsigned xb_add(unsigned* p, unsigned v) { return __hip_atomic_fetch_add(p, v, __ATOMIC_RELAXED, __HIP_MEMORY_SCOPE_AGENT); }
__device__ __forceinline__ unsigned xb_xcc_id() { return (unsigned)__builtin_amdgcn_s_getreg((3 << 11) | 20) & 0xFu; }
#define XB_SPIN(cond, bar) do { unsigned _sp = 0; while (cond) { __builtin_amdgcn_s_sleep(1); \
    if ((++_sp & 255u) == 0u) { if (xb_ld(&(bar)[XB_TMO])) break; if (_sp > XB_SPIN_CAP) { atomicAdd(&(bar)[XB_TMO], 1u); break; } } } } while (0)
struct XcdBarrier { unsigned* bar; unsigned x; volatile LAS unsigned* st; };
__device__ __forceinline__ XcdBarrier xcd_barrier_post(unsigned* bar, volatile LAS unsigned* st) {
    XcdBarrier b; b.bar = bar; b.x = xb_xcc_id(); b.st = st;
    if (threadIdx.x == 0) (void)xb_add(&bar[XB_XCNT(b.x)], 1u);
    return b;
}
__device__ __forceinline__ void xcd_barrier_complete(unsigned* bar, unsigned x, unsigned& nloc, unsigned& nx) {
    const unsigned G = gridDim.x * gridDim.y * gridDim.z;
    unsigned sum, cnt, mine, sp = 0u;
    for (;;) {
        sum = 0u; cnt = 0u; mine = 0u;
#pragma unroll
        for (unsigned j = 0; j < 16; ++j) { const unsigned c = xb_ld(&bar[XB_XCNT(j)]); sum += c; cnt += (c > 0u) ? 1u : 0u; mine = (j == x) ? c : mine; }
        if (sum == G) break;
        __builtin_amdgcn_s_sleep(1);
        if ((++sp & 255u) == 0u) { if (xb_ld(&bar[XB_TMO])) break; if (sp > XB_SPIN_CAP) { atomicAdd(&bar[XB_TMO], 1u); break; } }
    }
    nloc = mine > 0u ? mine : 1u; nx = cnt > 0u ? cnt : 1u;
}
__device__ __forceinline__ void xcd_barrier(const XcdBarrier& b) {
    asm volatile("s_waitcnt vmcnt(0)" ::: "memory");
    __syncthreads();
    if (threadIdx.x == 0) {
        unsigned* bar = b.bar;
        __builtin_amdgcn_s_waitcnt(0);
        unsigned nloc = b.st[0], nx = b.st[1];
        if (nloc == 0u) { xcd_barrier_complete(bar, b.x, nloc, nx); b.st[0] = nloc; b.st[1] = nx; }
        const unsigned old = xb_add(&bar[XB_XSUB(b.x)], 1u);
        const unsigned gen = old / nloc;
        if (old + 1u == (gen + 1u) * nloc) {
            __builtin_amdgcn_fence(__ATOMIC_RELEASE, "agent");
            asm volatile("s_waitcnt vmcnt(0)" ::: "memory");
            const unsigned og = xb_add(&bar[XB_TOP], 1u);
            const unsigned tg = og / nx;
            if (og + 1u == (tg + 1u) * nx) xb_add(&bar[XB_TOPGEN], 1u);
            else XB_SPIN(xb_ld(&bar[XB_TOPGEN]) == tg, bar);
            __builtin_amdgcn_fence(__ATOMIC_ACQUIRE, "agent");
            xb_add(&bar[XB_XGEN(b.x)], 1u);
            asm volatile("s_waitcnt vmcnt(0)" ::: "memory");
        } else {
            XB_SPIN(xb_ld(&bar[XB_XGEN(b.x)]) == gen, bar);
            __builtin_amdgcn_fence(__ATOMIC_ACQUIRE, "agent");
            asm volatile("s_waitcnt vmcnt(0)" ::: "memory");
        }
    }
    __syncthreads();
}

constexpr int NWAVES = 8;
constexpr int RING_OFF = 0, RING_BYTES = 135168;
constexpr int LDSCTL_OFF = RING_BYTES, MISC_OFF = LDSCTL_OFF + 320;
constexpr int LDS_BYTES = 147456;
static_assert(att::S_BYTES <= RING_BYTES && att::X_BYTES <= RING_BYTES && pg8::STAGE_BYTES <= RING_BYTES && MISC_OFF + 128 <= LDS_BYTES, "LDS map");
static_assert(ssd::A_BYTES <= RING_BYTES && ssd::C_BYTES <= RING_BYTES, "SSD scratch");

__device__ __forceinline__ float wave_sum(float v) {
#pragma unroll
    for (int o = 1; o < 64; o <<= 1) v += __shfl_xor(v, o);
    return v;
}
enum { WM_ID = 0, WM_IN = 1, WM_Q = 2, WM_KV = 3 };
__device__ __forceinline__ int srccol(int kind, int n) {
    if (kind == WM_IN) {
        if (n < PC_KR) return n < PC_QL ? n : n + 8;
        if (n < PC_DT) { const int i = n - PC_KR; return 2184 + (i >> 1) + 16 * (i & 1); }
        if (n < PC_DT + 8) return 1536 + (n - PC_DT);
        return -1;
    }
    if (kind == WM_Q) { const int h = n / 96, d = n % 96; if (d < 64) return n; const int i = d - 64; return h * 96 + 64 + (i >> 1) + 16 * (i & 1); }
    if (kind == WM_KV) { if (n < 512) return (n >> 6) * 128 + (n & 63); const int n2 = n - 512; return (n2 >> 6) * 128 + 64 + (n2 & 63); }
    return n;
}
__device__ __forceinline__ void transpose_item(const float* W, int K, int Nsrc, int Ndst, bf16* WT, int row_off, int kind, const float* rowscale, float cscale, LAS float* scr, int item, int lane) {
    const int nblk = Ndst / 32, kb = item / nblk, nb = item % nblk, k0 = 64 * kb, n0 = 32 * nb;
    const int sc = srccol(kind, n0 + (lane & 31));
#pragma unroll 8
    for (int i = 0; i < 32; ++i) { const int kk = 2 * i + (lane >> 5);
        float v = 0.f; if (sc >= 0) { v = W[(size_t)(k0 + kk) * Nsrc + sc] * cscale; if (rowscale) v *= rowscale[k0 + kk]; }
        scr[kk * 33 + (lane & 31)] = v; }
    asm volatile("s_waitcnt lgkmcnt(0)" ::: "memory");
    const int c = lane & 7;
#pragma unroll
    for (int j = 0; j < 4; ++j) { const int n = (lane >> 3) + 8 * j; const LAS float* s = scr + (8 * c) * 33 + n;
        u32x4 o; o.x = cvt_pk_bf16(s[0 * 33], s[1 * 33]); o.y = cvt_pk_bf16(s[2 * 33], s[3 * 33]); o.z = cvt_pk_bf16(s[4 * 33], s[5 * 33]); o.w = cvt_pk_bf16(s[6 * 33], s[7 * 33]);
        *(u32x4*)(WT + (size_t)(row_off + n0 + n) * K + k0 + 8 * c) = o; }
    asm volatile("s_waitcnt lgkmcnt(0)" ::: "memory");
}
__device__ __forceinline__ void ln_row(const float* urow, const float* g, const float* b, float* stats, bf16* xn, float* fo, int lane) {
    const f32x4* xr = (const f32x4*)urow + lane;
    f32x4 v[4]; float s = 0.f;
#pragma unroll
    for (int j = 0; j < 4; ++j) { v[j] = xr[64 * j]; s += (v[j][0] + v[j][1]) + (v[j][2] + v[j][3]); }
    const float mean = wave_sum(s) * (1.f / DM); float s2 = 0.f;
#pragma unroll
    for (int j = 0; j < 4; ++j) { v[j] = v[j] - mean; s2 += (v[j][0] * v[j][0] + v[j][1] * v[j][1]) + (v[j][2] * v[j][2] + v[j][3] * v[j][3]); }
    const float rstd = 1.f / sqrtf(wave_sum(s2) * (1.f / DM) + LN_EPS);
    if (stats && lane == 0) { stats[0] = mean; stats[1] = rstd; }
#pragma unroll
    for (int j = 0; j < 4; ++j) {
        const f32x4 gg = *((const f32x4*)g + lane + 64 * j), bb = *((const f32x4*)b + lane + 64 * j);
        const f32x4 y = v[j] * rstd * gg + bb;
        if (xn) { u32x2 w; w.x = cvt_pk_bf16(y[0], y[1]); w.y = cvt_pk_bf16(y[2], y[3]); *((u32x2*)xn + lane + 64 * j) = w; }
        if (fo) *((f32x4*)fo + lane + 64 * j) = y;
    }
}

enum { PH_PRO = 0, PH_INPROJ, PH_UP, PH_ATTN, PH_SSDC, PH_MIX, PH_LN1, PH_MEMQ, PH_XATT, PH_MEMO, PH_LN2, PH_FFUP, PH_FFDN, PH_LN3, NPH };
struct Args { const void* in[29]; float* out; unsigned char* ws; int ph_lo, ph_hi; };
static_assert(sizeof(Args) == 29 * 8 + 8 + 8 + 8, "Args has no padding");


#define INF(i) ((const float*)args.in[i])
#define x_        INF(0)
#define mem_      INF(1)
#define positions_ ((const int*)args.in[2])
#define ln_in_g   INF(3)
#define ln_in_b   INF(4)
#define w_in      INF(5)
#define conv_w    INF(6)
#define conv_b    INF(7)
#define dt_bias   INF(8)
#define a_log     INF(9)
#define d_skip    INF(10)
#define ssd_norm_g INF(11)
#define q_norm_g  INF(12)
#define w_q_up    INF(13)
#define kv_norm_g INF(14)
#define w_kv_up   INF(15)
#define w_mix_out INF(16)
#define ln1_g     INF(17)
#define ln1_b     INF(18)
#define w_mem_q   INF(19)
#define w_mem_k   INF(20)
#define w_mem_v   INF(21)
#define w_mem_o   INF(22)
#define ln2_g     INF(23)
#define ln2_b     INF(24)
#define w_up      INF(25)
#define w_down    INF(26)
#define ln3_g     INF(27)
#define ln3_b     INF(28)
#define WSP(T, off) ((T*)(args.ws + (off)))
#define STATS  WSP(float, WS_STATS)
#define CD     WSP(float, WS_CD)
#define Win_t  WSP(bf16, WS_WIN)
#define Wq_t   WSP(bf16, WS_WQ)
#define Wkv_t  WSP(bf16, WS_WKV)
#define Wmix_t WSP(bf16, WS_WMIX)
#define Wmq_t  WSP(bf16, WS_WMQ)
#define Wmkv_t WSP(bf16, WS_WMKV)
#define Wmo_t  WSP(bf16, WS_WMO)
#define Wup_t  WSP(bf16, WS_WUP)
#define Wdn_t  WSP(bf16, WS_WDN)
#define MEMB   WSP(bf16, WS_MEMB)
#define KM     WSP(bf16, WS_KM)
#define VM     WSP(bf16, WS_VM)
#define KPE    WSP(bf16, WS_KPE)
#define COS    WSP(float, WS_COS)
#define SIN    WSP(float, WS_SIN)
#define DT     WSP(float, WS_DT)
#define SSQ    WSP(float, WS_SSQ)
#define XN     WSP(bf16, WS_XN)
#define YO     WSP(bf16, WS_YO)
#define U2     WSP(float, WS_U2)
#define Qb     WSP(bf16, WS_Q)
#define KVb    WSP(bf16, WS_KV)
#define HB     WSP(bf16, WS_HB)
#define PROJ   WSP(bf16, WS_PROJ)
#define ST     WSP(float, WS_ST)
#define PREV   WSP(bf16, WS_PREV)
#define QM     WSP(bf16, WS_QM)
#define OM     WSP(bf16, WS_OM)
#define U1     (args.out)
#define OUT    (args.out)
__global__ void __launch_bounds__(NWAVES * 64, 2) layer_fwd(Args args) {
    extern __shared__ __attribute__((aligned(16))) unsigned char lds[];
    LAS unsigned char* ldsl = (LAS unsigned char*)lds;
    volatile LAS unsigned* MISC = (volatile LAS unsigned*)(ldsl + MISC_OFF);
    const int tid = threadIdx.x, lane = tid & 63, wave = __builtin_amdgcn_readfirstlane(tid >> 6);
    const int G = gridDim.x; const int bx = blockIdx.x; const int vcu = (G % 8 == 0) ? (bx % 8) * (G / 8) + bx / 8 : bx;
    gu32* ctl = (gu32*)(args.ws + WS_CTL);
    for (int u = tid; u < (LDS_BYTES - LDSCTL_OFF) / 4; u += NWAVES * 64) ((LAS unsigned*)(ldsl + LDSCTL_OFF))[u] = 0u;
    __syncthreads();
    const int lo = args.ph_lo, hi = args.ph_hi;
    const bool one_launch = (hi - lo) > 1;
    XcdBarrier bar; bar.bar = (unsigned*)(ctl + 4096); bar.x = 0; bar.st = nullptr;
    if (one_launch) bar = xcd_barrier_post((unsigned*)(ctl + 4096), MISC + 8);
#define IN(k) (lo <= (k) && (k) < hi)
#define SEAM(k) do { if (IN(k) && IN((k) + 1)) xcd_barrier(bar); } while (0)
    const int gw = vcu * NWAVES + wave, NGW = G * NWAVES;
    const int gt = vcu * (NWAVES * 64) + tid, NGT = G * NWAVES * 64;

    if (IN(PH_PRO)) {
        LAS float* scr = (LAS float*)(ldsl + RING_OFF + wave * 16384);
        constexpr int I_IN = (DM / 64) * (NPROJ / 32), I_Q = (384 / 64) * (NQ / 32), I_KV = (256 / 64) * (NKV / 32), I_SQ = (DM / 64) * (DM / 32), I_UP = (DM / 64) * (FF / 32), I_DN = (FF / 64) * (DM / 32);
        constexpr int NITEMS = I_IN + I_Q + I_KV + 5 * I_SQ + I_UP + I_DN;
        for (int it = gw; it < NITEMS; it += NGW) {
            int r = it;
            if (r < I_IN) { transpose_item(w_in, DM, 2216, NPROJ, Win_t, 0, WM_IN, nullptr, 1.f, scr, r, lane); continue; } r -= I_IN;
            if (r < I_Q) { transpose_item(w_q_up, 384, NQ, NQ, Wq_t, 0, WM_Q, q_norm_g, QSCALE, scr, r, lane); continue; } r -= I_Q;
            if (r < I_KV) { transpose_item(w_kv_up, 256, NKV, NKV, Wkv_t, 0, WM_KV, kv_norm_g, 1.f, scr, r, lane); continue; } r -= I_KV;
            if (r < I_SQ) { transpose_item(w_mix_out, DM, DM, DM, Wmix_t, 0, WM_ID, nullptr, 1.f, scr, r, lane); continue; } r -= I_SQ;
            if (r < I_SQ) { transpose_item(w_mem_q, DM, DM, DM, Wmq_t, 0, WM_ID, nullptr, MSCALE, scr, r, lane); continue; } r -= I_SQ;
            if (r < I_SQ) { transpose_item(w_mem_k, DM, DM, DM, Wmkv_t, 0, WM_ID, nullptr, 1.f, scr, r, lane); continue; } r -= I_SQ;
            if (r < I_SQ) { transpose_item(w_mem_v, DM, DM, DM, Wmkv_t, DM, WM_ID, nullptr, 1.f, scr, r, lane); continue; } r -= I_SQ;
            if (r < I_SQ) { transpose_item(w_mem_o, DM, DM, DM, Wmo_t, 0, WM_ID, nullptr, 1.f, scr, r, lane); continue; } r -= I_SQ;
            if (r < I_UP) { transpose_item(w_up, DM, FF, FF, Wup_t, 0, WM_ID, nullptr, 1.f, scr, r, lane); continue; } r -= I_UP;
            transpose_item(w_down, FF, DM, DM, Wdn_t, 0, WM_ID, nullptr, 1.f, scr, r, lane);
        }
        for (int i = gt; i < BATCH * MEMT * DM / 8; i += NGT) {
            const f32x4 a = *((const f32x4*)mem_ + 2 * (size_t)i), b = *((const f32x4*)mem_ + 2 * (size_t)i + 1);
            u32x4 w; w.x = cvt_pk_bf16(a[0], a[1]); w.y = cvt_pk_bf16(a[2], a[3]); w.z = cvt_pk_bf16(b[0], b[1]); w.w = cvt_pk_bf16(b[2], b[3]);
            *((u32x4*)MEMB + i) = w;
        }
        for (int i = gt; i < M * 16; i += NGT) {
            const int row = i >> 4, j = i & 15;
            const float invf = exp2f(-(float)j * (13.287712379549449f / 16.f));
            const float ang = (float)positions_[row] * invf;
            COS[i] = (float)cos((double)ang); SIN[i] = (float)sin((double)ang);
        }
        for (int m = gw; m < M; m += NGW) ln_row(x_ + (size_t)m * DM, ln_in_g, ln_in_b, STATS + (size_t)m * 2, XN + (size_t)m * DM, nullptr, lane);
    }
    SEAM(PH_PRO);

    if (IN(PH_INPROJ)) {
        pg8::Gemm g{XN, Win_t, M, NPROJ, DM, DM, DM}; pg8::StaticOrder S; S.init(M, NPROJ, G, bx);
        pg8::EpiP E{pg8::EK_PROJ, PROJ, NPROJ, SSQ, DT, dt_bias, nullptr, nullptr, nullptr, 0, 0};
        pg8::gemm_phase<pg8::EpiP, pg8::StaticOrder, true, true>(ldsl + RING_OFF, g, S, E);
    }
    SEAM(PH_INPROJ);

    if (IN(PH_UP)) {
        for (int i = gt; i < M * 4; i += NGT) {
            const int row = i >> 2, o8 = i & 3;
            const bf16x8 xv = *(const bf16x8*)(PROJ + (size_t)row * NPROJ + PC_KR + 8 * o8);
            const f32x4 cs = *(const f32x4*)(COS + (size_t)row * 16 + 4 * o8), sn = *(const f32x4*)(SIN + (size_t)row * 16 + 4 * o8);
            float v[8];
#pragma unroll
            for (int j = 0; j < 4; ++j) { const float x1 = bf2f((unsigned short)xv[2 * j]), x2 = bf2f((unsigned short)xv[2 * j + 1]); v[2 * j] = x1 * cs[j] - x2 * sn[j]; v[2 * j + 1] = x2 * cs[j] + x1 * sn[j]; }
            u32x4 w; w.x = cvt_pk_bf16(v[0], v[1]); w.y = cvt_pk_bf16(v[2], v[3]); w.z = cvt_pk_bf16(v[4], v[5]); w.w = cvt_pk_bf16(v[6], v[7]);
            *(u32x4*)(KPE + (size_t)row * 32 + 8 * o8) = w;
        }
        __syncthreads();
        { pg8::Gemm g{PROJ + PC_QL, Wq_t, M, NQ, 384, NPROJ, 384}; pg8::StaticOrder S; S.init(M, NQ, G, bx);
          pg8::EpiP E{pg8::EK_QUP, Qb, NQ, nullptr, nullptr, nullptr, SSQ, COS, SIN, 0, 0};
          pg8::gemm_phase<pg8::EpiP, pg8::StaticOrder, true, true>(ldsl + RING_OFF, g, S, E); }
        __syncthreads();
        { pg8::Gemm g{PROJ + PC_KVL, Wkv_t, M, NKV, 256, NPROJ, 256}; pg8::StaticOrder S; S.init(M, NKV, G, bx);
          pg8::EpiP E{pg8::EK_KVUP, KVb, NKV, nullptr, nullptr, nullptr, SSQ, nullptr, nullptr, 0, 0};
          pg8::gemm_phase<pg8::EpiP, pg8::StaticOrder, true, true>(ldsl + RING_OFF, g, S, E); }
        __syncthreads();
        { pg8::Gemm g{MEMB, Wmkv_t, BATCH * MEMT, 2 * DM, DM, DM, DM}; pg8::StaticOrder S; S.init(BATCH * MEMT, 2 * DM, G, bx);
          pg8::EpiP E{pg8::EK_PLAIN, KM, DM, nullptr, nullptr, nullptr, nullptr, nullptr, nullptr, DM, (long)((WS_VM - WS_KM) / 2)};
          pg8::gemm_phase<pg8::EpiP, pg8::StaticOrder, true, true>(ldsl + RING_OFF, g, S, E); }
        __syncthreads();
        for (int u = vcu; u < BATCH * NCHUNK * 2; u += G) ssd::pass_a_unit(u, PROJ, DT, a_log, conv_w, conv_b, ST, CD, (char*)lds + RING_OFF);
    }
    SEAM(PH_UP);

    if (IN(PH_ATTN)) {
        for (int id = gt; id < BATCH * 8 * 8192; id += NGT) {
            const int bh = id >> 13, e = id & 8191, b = bh >> 3, h = bh & 7;
            float st = 0.f;
            for (int c = 0; c < NCHUNK; ++c) {
                const size_t idx = ((((size_t)b * NCHUNK + c) * 8 + h) << 13) + e;
                PREV[idx] = (bf16)(cvt_pk_bf16(st, 0.f) & 0xffffu);
                st = st * CD[((size_t)b * NCHUNK + c) * 8 + h] + ST[idx];
            }
        }
        __syncthreads();
        if (G == 256) {
            for (int i = 0; i < 4; ++i) {
                const int s = vcu & 3, bh = vcu >> 2;
                const int qb = (i == 0) ? 15 - s : (i == 1) ? 8 + s : (i == 2) ? 7 - s : s;
                att::self_unit(bh >> 3, bh & 7, qb, Qb, KVb, KPE, YO, (char*)lds + RING_OFF);
            }
        } else {
            for (int u = vcu; u < BATCH * 8 * 16; u += G) att::self_unit(u >> 7, (u >> 4) & 7, u & 15, Qb, KVb, KPE, YO, (char*)lds + RING_OFF);
        }
    }
    SEAM(PH_ATTN);

    if (IN(PH_SSDC)) {
        for (int u = vcu; u < BATCH * NCHUNK * 2; u += G) ssd::pass_c_unit(u, PROJ, DT, a_log, conv_w, conv_b, PREV, d_skip, ssd_norm_g, ST  , YO, (char*)lds + RING_OFF);
    }
    SEAM(PH_SSDC);

    if (IN(PH_MIX)) {
        pg8::Gemm g{YO, Wmix_t, M, DM, DM, DM, DM}; pg8::StaticOrder S; S.init(M, DM, G, bx);
        pg8::EpiR E{x_, STATS, ln_in_g, ln_in_b, U1};
        pg8::gemm_phase<pg8::EpiR, pg8::StaticOrder, true, true>(ldsl + RING_OFF, g, S, E);
    }
    SEAM(PH_MIX);
    if (IN(PH_LN1)) { for (int m = gw; m < M; m += NGW) ln_row(U1 + (size_t)m * DM, ln1_g, ln1_b, STATS + (size_t)M * 2 + (size_t)m * 2, XN + (size_t)m * DM, nullptr, lane); }
    SEAM(PH_LN1);

    if (IN(PH_MEMQ)) {
        pg8::Gemm g{XN, Wmq_t, M, DM, DM, DM, DM}; pg8::StaticOrder S; S.init(M, DM, G, bx);
        pg8::EpiP E{pg8::EK_PLAIN, QM, DM, nullptr, nullptr, nullptr, nullptr, nullptr, nullptr, 0, 0};
        pg8::gemm_phase<pg8::EpiP, pg8::StaticOrder, true, true>(ldsl + RING_OFF, g, S, E);
    }
    SEAM(PH_MEMQ);

    if (IN(PH_XATT)) {
        for (int u = vcu; u < BATCH * 4 * (SEQ / 128); u += G) {
            const int qt = u & 31, bh = u >> 5;
            att::cross_unit(bh >> 2, bh & 3, qt, QM, KM, VM, OM, (char*)lds + RING_OFF);
        }
    }
    SEAM(PH_XATT);

    if (IN(PH_MEMO)) {
        pg8::Gemm g{OM, Wmo_t, M, DM, DM, DM, DM}; pg8::StaticOrder S; S.init(M, DM, G, bx);
        pg8::EpiR E{U1, STATS + (size_t)M * 2, ln1_g, ln1_b, U2};
        pg8::gemm_phase<pg8::EpiR, pg8::StaticOrder, true, true>(ldsl + RING_OFF, g, S, E);
    }
    SEAM(PH_MEMO);
    if (IN(PH_LN2)) { for (int m = gw; m < M; m += NGW) ln_row(U2 + (size_t)m * DM, ln2_g, ln2_b, STATS + (size_t)M * 4 + (size_t)m * 2, XN + (size_t)m * DM, nullptr, lane); }
    SEAM(PH_LN2);

    if (IN(PH_FFUP)) {
        pg8::Gemm g{XN, Wup_t, M, FF, DM, DM, DM}; pg8::StaticOrder S; S.init(M, FF, G, bx);
        pg8::EpiP E{pg8::EK_SQRELU, HB, FF, nullptr, nullptr, nullptr, nullptr, nullptr, nullptr, 0, 0};
        pg8::gemm_phase<pg8::EpiP, pg8::StaticOrder, true, true>(ldsl + RING_OFF, g, S, E);
    }
    SEAM(PH_FFUP);

    if (IN(PH_FFDN)) {
        pg8::Gemm g{HB, Wdn_t, M, DM, FF, FF, FF}; pg8::StaticOrder S; S.init(M, DM, G, bx);
        pg8::EpiR E{U2, STATS + (size_t)M * 4, ln2_g, ln2_b, OUT};
        pg8::gemm_phase<pg8::EpiR, pg8::StaticOrder, true, true>(ldsl + RING_OFF, g, S, E);
    }
    SEAM(PH_FFDN);
    if (IN(PH_LN3)) { for (int m = gw; m < M; m += NGW) ln_row(OUT + (size_t)m * DM, ln3_g, ln3_b, nullptr, nullptr, OUT + (size_t)m * DM, lane); }
#undef IN
#undef SEAM
}

extern "C" void kernel_launch(void* const* d_in, const int* in_sizes, int n_in, void* d_out, int out_size, void* d_ws, size_t ws_size, hipStream_t stream) {
    static int grid = 0;
    if (grid == 0) {
        if (n_in != 29 || in_sizes[0] != M * DM || out_size != M * DM || ws_size < WS_END) {
            fprintf(stderr, "kernel_launch: unexpected shapes: n_in %d in0 %d out %d ws %zu (need >= %zu)\n", n_in, n_in > 0 ? in_sizes[0] : -1, out_size, ws_size, (size_t)WS_END); grid = -1; return; }
        int dev = 0, cus = 0;
        if (hipGetDevice(&dev) != hipSuccess || hipDeviceGetAttribute(&cus, hipDeviceAttributeMultiprocessorCount, dev) != hipSuccess) { fprintf(stderr, "kernel_launch: device query failed\n"); grid = -1; return; }
        if (hipFuncSetAttribute((const void*)layer_fwd, hipFuncAttributeMaxDynamicSharedMemorySize, LDS_BYTES) != hipSuccess) { fprintf(stderr, "kernel_launch: hipFuncSetAttribute failed\n"); grid = -1; return; }
        (void)hipGetLastError();
        grid = cus;
    }
    if (grid < 0) return;
    if (hipMemsetAsync((char*)d_ws + WS_CTL, 0, CTL_ZERO_BYTES, stream) != hipSuccess) { fprintf(stderr, "kernel_launch: memset failed\n"); return; }
    Args a{};
    for (int i = 0; i < 29; ++i) a.in[i] = d_in[i];
    a.out = (float*)d_out; a.ws = (unsigned char*)d_ws;
#if MK_PER_PHASE
    for (int p = 0; p < NPH; ++p) { a.ph_lo = p; a.ph_hi = p + 1; hipLaunchKernelGGL(layer_fwd, dim3(grid), dim3(NWAVES * 64), LDS_BYTES, stream, a); }
#else
    a.ph_lo = 0; a.ph_hi = NPH; hipLaunchKernelGGL(layer_fwd, dim3(grid), dim3(NWAVES * 64), LDS_BYTES, stream, a);
#endif
    const hipError_t le = hipPeekAtLastError();
    if (le != hipSuccess) fprintf(stderr, "kernel_launch: launch failed: %s\n", hipGetErrorName(le));
}
```
